# Optimizing an MI355X kernel written in HIP

```python
import math
import jax
import jax.numpy as jnp
from jax import lax
import numpy as np

D_MODEL = 1024
BATCH = 32
SEQ = 256
DEPTH = 2
DEC_BATCH = 8
DEC_SEQ = 1024
PAST_LEN = 256

GRID_W = 64
HEAD_DIM = 64
A_HEADS = 8
A_KV_HEADS = 2
A_GROUP = A_HEADS // A_KV_HEADS
A_WIDTH = A_HEADS * HEAD_DIM
B_HEADS = 4
B_QK_DIM = 32
B_V_DIM = 64
B_WIDTH = B_HEADS * B_V_DIM
C_HEADS = 4
C_DK = 32
C_DV = 64
C_WIDTH = C_HEADS * C_DV
GATE_RANK = 16
GLA_TAU = 16.0
CHUNK = 64
D_MIX = A_WIDTH + B_WIDTH + C_WIDTH
Q_BLOCK = 128
ROPE_THETA = 10000.0
EPS = 1e-6
IN_SIZES = (A_WIDTH, A_KV_HEADS * HEAD_DIM, A_KV_HEADS * HEAD_DIM,
            B_HEADS * 2 * B_QK_DIM, B_HEADS * 2 * B_QK_DIM, B_WIDTH,
            C_HEADS * C_DK, C_HEADS * C_DK, C_WIDTH, 2 * GATE_RANK, D_MIX)
IN_WIDTH = sum(IN_SIZES)

kernel_name = 'hybrid_diffusion_parallel_heads_step'


def rms_norm(x, g):
    xf = x.astype(jnp.float32)
    y = xf * lax.rsqrt(jnp.mean(xf * xf, axis=-1, keepdims=True) + EPS)
    return (y * g.astype(jnp.float32)).astype(x.dtype)


def split_heads(t, n_heads):
    b, l, _ = t.shape
    return t.reshape(b, l, n_heads, -1).transpose(0, 2, 1, 3)


def merge_heads(t):
    b, n, l, d = t.shape
    return t.transpose(0, 2, 1, 3).reshape(b, l, n * d)


def rope_1d(x, pos):
    half = x.shape[-1] // 2
    freq = ROPE_THETA ** (-jnp.arange(half, dtype=jnp.float32) / half)
    ang = pos.astype(jnp.float32)[:, None] * freq[None, :]
    cos, sin = jnp.cos(ang), jnp.sin(ang)
    xf = x.astype(jnp.float32)
    x1, x2 = xf[..., :half], xf[..., half:]
    return jnp.concatenate([x1 * cos - x2 * sin, x2 * cos + x1 * sin], axis=-1)


def rope_2d(x, pos_row, pos_col):
    d = x.shape[-1] // 2
    return jnp.concatenate([rope_1d(x[..., :d], pos_row), rope_1d(x[..., d:], pos_col)], axis=-1).astype(x.dtype)


def sweep_query_blocks(attend, q):
    lead = q.shape[:-2]
    lq, d = q.shape[-2], q.shape[-1]
    nb = lq // Q_BLOCK
    qb = jnp.moveaxis(q.reshape(*lead, nb, Q_BLOCK, d), -3, 0)
    ob = lax.map(attend, qb)
    return jnp.moveaxis(ob, 0, -3).reshape(*lead, lq, ob.shape[-1])


def gqa_attention(q, k, v):
    scale = q.shape[-1] ** -0.5

    def attend(qb):
        s = jnp.einsum('bkgqd,bksd->bkgqs', qb, k).astype(jnp.float32) * scale
        p = jax.nn.softmax(s, axis=-1).astype(v.dtype)
        return jnp.einsum('bkgqs,bksd->bkgqd', p, v)

    return sweep_query_blocks(attend, q)


def diff_attention(q, k, v, lam):
    scale = B_QK_DIM ** -0.5
    k1, k2 = k[..., :B_QK_DIM], k[..., B_QK_DIM:]
    lam32 = lam.astype(jnp.float32)

    def attend(qb):
        s1 = jnp.einsum('bhqd,bhsd->bhqs', qb[..., :B_QK_DIM], k1).astype(jnp.float32) * scale
        s2 = jnp.einsum('bhqd,bhsd->bhqs', qb[..., B_QK_DIM:], k2).astype(jnp.float32) * scale
        a = jax.nn.softmax(s1, axis=-1) - lam32 * jax.nn.softmax(s2, axis=-1)
        return jnp.einsum('bhqs,bhsd->bhqd', a.astype(v.dtype), v)

    return sweep_query_blocks(attend, q)


def gla_scan(q, k, v, g, s0):
    b, h, l, _ = q.shape
    n = l // CHUNK

    def to_chunks(t):
        return jnp.moveaxis(t.reshape(b, h, n, CHUNK, t.shape[-1]), 2, 0)

    mask = jnp.tril(jnp.ones((CHUNK, CHUNK), dtype=bool))

    def step(s, inp):
        qc, kc, vc, gc = inp
        cum = jnp.cumsum(gc, axis=-2)
        q_t = qc * jnp.exp(cum)
        k_t = kc * jnp.exp(-cum)
        a = jnp.where(mask, jnp.einsum('bhid,bhjd->bhij', q_t, k_t), 0.0)
        o = jnp.einsum('bhid,bhde->bhie', q_t, s) + jnp.einsum('bhij,bhje->bhie', a, vc)
        last = cum[..., -1:, :]
        s_new = jnp.exp(last)[..., 0, :, None] * s + jnp.einsum('bhjd,bhje->bhde', kc * jnp.exp(last - cum), vc)
        return s_new, o

    s_fin, o = lax.scan(step, s0, (to_chunks(q), to_chunks(k), to_chunks(v), to_chunks(g)))
    o = jnp.moveaxis(o, 0, 2).reshape(b, h, l, v.shape[-1])
    return o, s_fin


def gla_bidirectional(q, k, v, g_f, g_b, s_f0, s_b0):
    o_f, s_f = gla_scan(q, k, v, g_f, s_f0)
    flip = lambda t: jnp.flip(t, axis=2)
    o_b, s_b = gla_scan(flip(q), flip(k), flip(v), flip(g_b), s_b0)
    return o_f + flip(o_b), s_f, s_b


def trunk_layer(x, mod, lp, lam, lam_init, pos, ctx):
    (g_pre, g_post, w_in, w_out, a_q_gain, a_k_gain, b_out_gain,
     c_w_f, c_b_f, c_w_b, c_b_b, c_out_gain) = lp
    bsz, l, _ = x.shape
    f32 = jnp.float32
    shift, scale, gate = jnp.split(mod, 3, axis=-1)
    h = rms_norm(x, g_pre) * (1.0 + scale[:, None, :]) + shift[:, None, :]
    z = h @ w_in
    (a_q, a_k, a_v, b_q, b_k, b_v, c_q, c_k, c_v, c_lr, u) = jnp.split(
        z, np.cumsum(IN_SIZES)[:-1].tolist(), axis=-1)

    a_q = rms_norm(split_heads(a_q, A_HEADS), a_q_gain)
    a_k = rms_norm(split_heads(a_k, A_KV_HEADS), a_k_gain)
    a_v = split_heads(a_v, A_KV_HEADS)
    b_q = split_heads(b_q, B_HEADS)
    b_k = split_heads(b_k, B_HEADS)
    b_v = split_heads(b_v, B_HEADS)
    c_q = split_heads(c_q, C_HEADS).astype(f32) * (C_DK ** -0.5)
    c_k = split_heads(c_k, C_HEADS).astype(f32)
    c_v = split_heads(c_v, C_HEADS).astype(f32)
    g_f = split_heads(jax.nn.log_sigmoid((c_lr[..., :GATE_RANK] @ c_w_f + c_b_f).astype(f32)) / GLA_TAU, C_HEADS)
    g_b = split_heads(jax.nn.log_sigmoid((c_lr[..., GATE_RANK:] @ c_w_b + c_b_b).astype(f32)) / GLA_TAU, C_HEADS)

    if ctx is None:
        a_k_all, a_v_all, b_k_all, b_v_all = a_k, a_v, b_k, b_v
        s_f0 = jnp.zeros((bsz, C_HEADS, C_DK, C_DV), f32)
        s_b0 = jnp.zeros((bsz, C_HEADS, C_DK, C_DV), f32)
    else:
        pos_row, pos_col = pos
        ck_a, cv_a, ck_b, cv_b, cs_f, cs_b = ctx
        a_q = rope_2d(a_q, pos_row, pos_col)
        a_k = rope_2d(a_k, pos_row, pos_col)
        b_q = jnp.concatenate([rope_2d(b_q[..., :B_QK_DIM], pos_row, pos_col),
                               rope_2d(b_q[..., B_QK_DIM:], pos_row, pos_col)], axis=-1)
        b_k = jnp.concatenate([rope_2d(b_k[..., :B_QK_DIM], pos_row, pos_col),
                               rope_2d(b_k[..., B_QK_DIM:], pos_row, pos_col)], axis=-1)
        a_k_all = jnp.concatenate([ck_a.astype(a_k.dtype), a_k], axis=2)
        a_v_all = jnp.concatenate([cv_a.astype(a_v.dtype), a_v], axis=2)
        b_k_all = jnp.concatenate([ck_b.astype(b_k.dtype), b_k], axis=2)
        b_v_all = jnp.concatenate([cv_b.astype(b_v.dtype), b_v], axis=2)
        s_f0 = cs_f.astype(f32)
        s_b0 = cs_b.astype(f32)

    o_a = gqa_attention(a_q.reshape(bsz, A_KV_HEADS, A_GROUP, l, HEAD_DIM), a_k_all, a_v_all)
    o_a = o_a.reshape(bsz, A_HEADS, l, HEAD_DIM)
    o_b = rms_norm(diff_attention(b_q, b_k_all, b_v_all, lam), b_out_gain) * (1.0 - lam_init)
    o_c, s_f, s_b = gla_bidirectional(c_q, c_k, c_v, g_f, g_b, s_f0, s_b0)
    o_c = rms_norm(o_c.astype(x.dtype), c_out_gain)

    mixed = jnp.concatenate([merge_heads(o_a), merge_heads(o_b), merge_heads(o_c)], axis=-1) * jax.nn.silu(u)
    y = mixed @ w_out
    x_new = x + gate[:, None, :] * rms_norm(y, g_post)
    if ctx is None:
        return x_new, (a_k, a_v, b_k, b_v, s_f.astype(x.dtype), s_b.astype(x.dtype))
    return x_new, None


def setup_inputs(seed: int = 0) -> dict:
    key = jax.random.key(seed)
    ks = jax.random.split(key, 28)
    f32 = jnp.float32

    def nrm(k, shape, s):
        return jax.random.normal(k, shape, f32) * s

    return {
        'x_prompt': nrm(ks[0], (BATCH, SEQ, D_MODEL), 1.0),
        'x_sample': nrm(ks[1], (DEC_BATCH, DEC_SEQ, D_MODEL), 1.0),
        'c': nrm(ks[2], (DEC_BATCH, D_MODEL), 1.0),
        'cache_a_k': nrm(ks[3], (DEC_BATCH, DEPTH, A_KV_HEADS, PAST_LEN, HEAD_DIM), 1.0),
        'cache_a_v': nrm(ks[4], (DEC_BATCH, DEPTH, A_KV_HEADS, PAST_LEN, HEAD_DIM), 1.0),
        'cache_b_k': nrm(ks[5], (DEC_BATCH, DEPTH, B_HEADS, PAST_LEN, 2 * B_QK_DIM), 1.0),
        'cache_b_v': nrm(ks[6], (DEC_BATCH, DEPTH, B_HEADS, PAST_LEN, B_V_DIM), 1.0),
        'state_c_fwd': nrm(ks[7], (DEC_BATCH, DEPTH, C_HEADS, C_DK, C_DV), 1.0),
        'state_c_bwd': nrm(ks[8], (DEC_BATCH, DEPTH, C_HEADS, C_DK, C_DV), 1.0),
        'c_ctx': nrm(ks[9], (D_MODEL,), 1.0),
        'w_mod': nrm(ks[10], (DEPTH, D_MODEL, 3 * D_MODEL), D_MODEL ** -0.5),
        'b_mod': nrm(ks[11], (DEPTH, 3 * D_MODEL), 0.02),
        'g_pre': 1.0 + nrm(ks[12], (DEPTH, D_MODEL), 0.02),
        'g_post': 1.0 + nrm(ks[13], (DEPTH, D_MODEL), 0.02),
        'w_in': nrm(ks[14], (DEPTH, D_MODEL, IN_WIDTH), D_MODEL ** -0.5),
        'w_out': nrm(ks[15], (DEPTH, D_MIX, D_MODEL), D_MIX ** -0.5),
        'a_q_gain': 1.0 + nrm(ks[16], (DEPTH, HEAD_DIM), 0.02),
        'a_k_gain': 1.0 + nrm(ks[17], (DEPTH, HEAD_DIM), 0.02),
        'b_lambda_q1': nrm(ks[18], (DEPTH, B_QK_DIM), 0.1),
        'b_lambda_k1': nrm(ks[19], (DEPTH, B_QK_DIM), 0.1),
        'b_lambda_q2': nrm(ks[20], (DEPTH, B_QK_DIM), 0.1),
        'b_lambda_k2': nrm(ks[21], (DEPTH, B_QK_DIM), 0.1),
        'b_out_gain': 1.0 + nrm(ks[22], (DEPTH, B_V_DIM), 0.02),
        'c_gate_w_fwd': nrm(ks[23], (DEPTH, GATE_RANK, C_HEADS * C_DK), GATE_RANK ** -0.5),
        'c_gate_b_fwd': nrm(ks[24], (DEPTH, C_HEADS * C_DK), 0.02),
        'c_gate_w_bwd': nrm(ks[25], (DEPTH, GATE_RANK, C_HEADS * C_DK), GATE_RANK ** -0.5),
        'c_gate_b_bwd': nrm(ks[26], (DEPTH, C_HEADS * C_DK), 0.02),
        'c_out_gain': 1.0 + nrm(ks[27], (DEPTH, C_DV), 0.02),
    }


def reference(x_prompt, x_sample, c, cache_a_k, cache_a_v, cache_b_k, cache_b_v, state_c_fwd, state_c_bwd,
              c_ctx, w_mod, b_mod, g_pre, g_post, w_in, w_out, a_q_gain, a_k_gain,
              b_lambda_q1, b_lambda_k1, b_lambda_q2, b_lambda_k2, b_out_gain,
              c_gate_w_fwd, c_gate_b_fwd, c_gate_w_bwd, c_gate_b_bwd, c_out_gain):
    rows = x_sample.shape[1] // GRID_W
    t = jnp.arange(rows * GRID_W)
    pos = (t // GRID_W, t % GRID_W)
    lam_base = (jnp.exp(jnp.sum(b_lambda_q1.astype(jnp.float32) * b_lambda_k1.astype(jnp.float32), axis=-1))
                - jnp.exp(jnp.sum(b_lambda_q2.astype(jnp.float32) * b_lambda_k2.astype(jnp.float32), axis=-1)))

    y_p, y_s = x_prompt, x_sample
    ctx_layers = []
    for l in range(DEPTH):
        lam_init = 0.8 - 0.6 * math.exp(-0.3 * l)
        lam = lam_base[l] + lam_init
        lp = (g_pre[l], g_post[l], w_in[l], w_out[l], a_q_gain[l], a_k_gain[l], b_out_gain[l],
              c_gate_w_fwd[l], c_gate_b_fwd[l], c_gate_w_bwd[l], c_gate_b_bwd[l], c_out_gain[l])
        mod_ctx = (jax.nn.silu(c_ctx) @ w_mod[l] + b_mod[l])[None, :]
        mod_lat = jax.nn.silu(c) @ w_mod[l] + b_mod[l]
        y_p, ctx_l = trunk_layer(y_p, mod_ctx, lp, lam, lam_init, None, None)
        ctx_cache = (cache_a_k[:, l], cache_a_v[:, l], cache_b_k[:, l], cache_b_v[:, l],
                     state_c_fwd[:, l], state_c_bwd[:, l])
        y_s, _ = trunk_layer(y_s, mod_lat, lp, lam, lam_init, pos, ctx_cache)
        ctx_layers.append(ctx_l)

    new_a_k, new_a_v, new_b_k, new_b_v, new_state_c_fwd, new_state_c_bwd = [
        jnp.stack(ts, axis=1) for ts in zip(*ctx_layers)]
    return (y_p, y_s, new_a_k, new_a_v, new_b_k, new_b_v, new_state_c_fwd, new_state_c_bwd)
```

```cpp
#include <hip/hip_runtime.h>
#include <hip/hip_cooperative_groups.h>
#include <cstdio>
#include <cstdint>
namespace cg = cooperative_groups;

typedef unsigned short u16;
typedef short bf16x8 __attribute__((ext_vector_type(8)));
typedef float f32x4 __attribute__((ext_vector_type(4)));
typedef unsigned u32x4 __attribute__((ext_vector_type(4)));
typedef unsigned u32x2 __attribute__((ext_vector_type(2)));

#ifndef PROBE_MASK
#define PROBE_MASK 0
#endif
#ifndef PROBE_DUP
#define PROBE_DUP 0
#endif
#define N_LAUNCH_SPLIT 0

constexpr int NTOK = 16384, DM = 1024, NIN = 3104, NINP = 3200;
constexpr int NTHREADS = 512;
constexpr int VT = 256;
constexpr float EPS = 1e-6f;

constexpr size_t WS_WIN  = 0;
constexpr size_t WS_WOUT = WS_WIN  + (size_t)2 * NINP * DM * 2;
constexpr size_t WS_MOD  = WS_WOUT + (size_t)2 * DM * DM * 2;
constexpr size_t WS_ROPE = WS_MOD  + (size_t)2 * 9 * 3072 * 4;
constexpr size_t WS_CTR  = WS_ROPE + 64 * 16 * 8;
constexpr size_t WS_H    = WS_CTR  + 256;
constexpr size_t WS_Z    = WS_H    + (size_t)NTOK * DM * 2;
constexpr size_t WS_MIX  = WS_Z    + (size_t)NTOK * NIN * 2;
constexpr size_t WS_KA   = WS_MIX  + (size_t)NTOK * DM * 2;
constexpr size_t KA_ELEMS = (size_t)(32 * 2 * 256 + 8 * 2 * 1280) * 64;
constexpr size_t KB_ELEMS = (size_t)(32 * 4 * 256 + 8 * 4 * 1280) * 64;
constexpr size_t CV_ELEMS = (size_t)(32 * 4 * 256 + 8 * 4 * 1024) * 64;
constexpr size_t WS_VAT  = WS_KA  + KA_ELEMS * 2;
constexpr size_t WS_KB   = WS_VAT + KA_ELEMS * 2;
constexpr size_t WS_VBT  = WS_KB  + KB_ELEMS * 2;
constexpr size_t WS_CVT  = WS_VBT + KB_ELEMS * 2;
constexpr size_t WS_OC   = WS_CVT + CV_ELEMS * 2;
constexpr size_t WS_G    = WS_OC  + (size_t)NTOK * 256 * 4;
constexpr size_t WS_BAR  = WS_G   + (size_t)NTOK * 256 * 4;
constexpr size_t WS_END  = WS_BAR + 3456 * 4;

constexpr size_t OUT_Y   = 0;
constexpr size_t OUT_AK  = 16777216;
constexpr size_t OUT_AV  = OUT_AK + 2097152;
constexpr size_t OUT_BK  = OUT_AV + 2097152;
constexpr size_t OUT_BV  = OUT_BK + 4194304;
constexpr size_t OUT_SF  = OUT_BV + 4194304;
constexpr size_t OUT_SB  = OUT_SF + 524288;

struct Params {
    const float* in[28];
    float* out;
    unsigned char* ws;
};
typedef const __attribute__((address_space(4))) Params* PP;
enum { I_XP = 0, I_XS, I_C, I_CAK, I_CAV, I_CBK, I_CBV, I_SCF, I_SCB, I_CCTX, I_WMOD, I_BMOD, I_GPRE, I_GPOST, I_WIN, I_WOUT,
       I_AQG, I_AKG, I_LQ1, I_LK1, I_LQ2, I_LK2, I_BOG, I_CWF, I_CBF, I_CWB, I_CBB, I_COG };

__device__ __forceinline__ int opaque_tid() { int t = threadIdx.x; asm volatile("" : "+v"(t)); return t; }
__device__ __forceinline__ int vtid() { return opaque_tid() & 255; }
__device__ __forceinline__ int half_id() { return __builtin_amdgcn_readfirstlane(threadIdx.x >> 8); }
typedef __bf16 bf16x2_t __attribute__((ext_vector_type(2)));
typedef float f32x2_t __attribute__((ext_vector_type(2)));
__device__ __forceinline__ unsigned pk2(float lo, float hi) { const f32x2_t v = {lo, hi}; return __builtin_bit_cast(unsigned, __builtin_convertvector(v, bf16x2_t)); }
__device__ __forceinline__ float bflo(unsigned w) { return __uint_as_float(w << 16); }
__device__ __forceinline__ float bfhi(unsigned w) { return __uint_as_float(w & 0xffff0000u); }
__device__ __forceinline__ float fast_exp2(float x) { return __builtin_amdgcn_exp2f(x); }
__device__ __forceinline__ float silu_f(float v) { return v * __builtin_amdgcn_rcpf(1.f + __expf(-v)); }
template <int CTRL> __device__ __forceinline__ float dppf(float v) { return __int_as_float(__builtin_amdgcn_mov_dpp(__float_as_int(v), CTRL, 0xf, 0xf, true)); }
__device__ __forceinline__ float xor1f(float v) { return dppf<0xB1>(v); }
__device__ __forceinline__ float xor2f(float v) { return dppf<0x4E>(v); }
__device__ __forceinline__ float sum8(float v) { v += xor1f(v); v += xor2f(v); v += dppf<0x141>(v); return v; }
__device__ __forceinline__ float sum16(float v) { v = sum8(v); v += dppf<0x140>(v); return v; }
__device__ __forceinline__ float rows_sum(float v) {
    unsigned u = __float_as_uint(v);
    auto r = __builtin_amdgcn_permlane16_swap(u, u, false, false);
    v = __uint_as_float(r[0]) + __uint_as_float(r[1]);
    u = __float_as_uint(v);
    auto r2 = __builtin_amdgcn_permlane32_swap(u, u, false, false);
    return __uint_as_float(r2[0]) + __uint_as_float(r2[1]);
}
__device__ __forceinline__ float wave_sum(float v) { return rows_sum(sum16(v)); }
__device__ __forceinline__ f32x4 mfma16(bf16x8 a, bf16x8 b, f32x4 c) { return __builtin_amdgcn_mfma_f32_16x16x32_bf16(a, b, c, 0, 0, 0); }
__device__ __forceinline__ bf16x8 as_bf8(u32x4 v) { return __builtin_bit_cast(bf16x8, v); }
__device__ __forceinline__ int swz(int row, int chunk) { return row * 128 + ((chunk ^ ((row >> 1) & 7)) << 4); }
__device__ __forceinline__ size_t kv_off(int grp, int b, int h, int H, int LS) {
    return grp ? ((size_t)32 * H * 256 + (size_t)(b * H + h) * LS) * 64 : (size_t)(b * H + h) * 256 * 64;
}

__device__ void prep_phase(PP p, unsigned char* smem) {
    const int tid = vtid(), lane = tid & 63, w = __builtin_amdgcn_readfirstlane(tid >> 6), hb = half_id();
    constexpr int NMOD = 192, NT_IN = 16 * 50, NT_OUT = 16 * 16;
    constexpr int NITEMS = NMOD + 2 * (NT_IN + NT_OUT) + 1;
    float* MODW = (float*)(p->ws + WS_MOD);
    for (int it0 = blockIdx.x * 2; it0 < NITEMS + 1; it0 += gridDim.x * 2) {
        const int it = it0 + hb;
        asm volatile("" : "+s"(p));
        if (it < NMOD) {
            const int l = it / 96, cgp = it % 96;
            float* red = (float*)smem;
            const int cq = tid & 7, kg = tid >> 3;
            const float* wp = p->in[I_WMOD] + (size_t)l * 1024 * 3072 + cgp * 32 + cq * 4;
            const float* cc = p->in[I_C]; const float* cx = p->in[I_CCTX];
            float acc[9][4];
#pragma unroll
            for (int r = 0; r < 9; ++r) { acc[r][0] = 0.f; acc[r][1] = 0.f; acc[r][2] = 0.f; acc[r][3] = 0.f; }
#pragma unroll 4
            for (int kk = 0; kk < 32; ++kk) {
                const int k = kg * 32 + kk;
                const float4 w4 = *(const float4*)(wp + (size_t)k * 3072);
                float cv[9];
                cv[0] = cx[k];
#pragma unroll
                for (int r = 1; r < 9; ++r) cv[r] = cc[(r - 1) * 1024 + k];
#pragma unroll
                for (int r = 0; r < 9; ++r) { const float s = cv[r] * __builtin_amdgcn_rcpf(1.f + __expf(-cv[r])); acc[r][0] += s * w4.x; acc[r][1] += s * w4.y; acc[r][2] += s * w4.z; acc[r][3] += s * w4.w; }
            }
#pragma unroll
            for (int r = 0; r < 9; ++r)
#pragma unroll
                for (int j = 0; j < 4; ++j) { float v = acc[r][j]; v += dppf<0x128>(v); v = rows_sum(v); acc[r][j] = v; }
            if ((lane >> 3) == 0) {
#pragma unroll
                for (int r = 0; r < 9; ++r)
#pragma unroll
                    for (int j = 0; j < 4; ++j) red[(w * 9 + r) * 32 + cq * 4 + j] = acc[r][j];
            }
            __syncthreads();
            for (int i = tid; i < 288; i += VT) {
                const int r = i >> 5, c = i & 31;
                const float v = red[(0 * 9 + r) * 32 + c] + red[(1 * 9 + r) * 32 + c] + red[(2 * 9 + r) * 32 + c] + red[(3 * 9 + r) * 32 + c] + p->in[I_BMOD][l * 3072 + cgp * 32 + c];
                MODW[(size_t)(l * 9 + r) * 3072 + cgp * 32 + c] = v;
            }
        } else if (it < NITEMS - 1) {
            int r = it - NMOD;
            const float* src; u16* dst; int N, NT;
            if (r < 2 * NT_IN) { const int l = r / NT_IN; r %= NT_IN; src = p->in[I_WIN] + (size_t)l * 1024 * NIN; dst = (u16*)(p->ws + WS_WIN) + (size_t)l * NINP * DM; N = NIN; NT = 50; }
            else { r -= 2 * NT_IN; const int l = r / NT_OUT; r %= NT_OUT; src = p->in[I_WOUT] + (size_t)l * 1024 * 1024; dst = (u16*)(p->ws + WS_WOUT) + (size_t)l * DM * DM; N = 1024; NT = 16; }
            const int kt = r / NT, nt = r % NT, k0 = kt * 64, n0 = nt * 64;
            float* T = (float*)smem;
#pragma unroll
            for (int i = 0; i < 4; ++i) {
                const int rr = (tid >> 4) + 16 * i, c = (tid & 15) * 4;
                float4 v = make_float4(0.f, 0.f, 0.f, 0.f);
                if (n0 + c < N) v = *(const float4*)(src + (size_t)(k0 + rr) * N + n0 + c);
                T[rr * 65 + c] = v.x; T[rr * 65 + c + 1] = v.y; T[rr * 65 + c + 2] = v.z; T[rr * 65 + c + 3] = v.w;
            }
            __syncthreads();
            const int n = tid >> 2, kq = tid & 3;
            u32x4 o0, o1;
            o0.x = pk2(T[(kq * 16 + 0) * 65 + n], T[(kq * 16 + 1) * 65 + n]);   o0.y = pk2(T[(kq * 16 + 2) * 65 + n], T[(kq * 16 + 3) * 65 + n]);
            o0.z = pk2(T[(kq * 16 + 4) * 65 + n], T[(kq * 16 + 5) * 65 + n]);   o0.w = pk2(T[(kq * 16 + 6) * 65 + n], T[(kq * 16 + 7) * 65 + n]);
            o1.x = pk2(T[(kq * 16 + 8) * 65 + n], T[(kq * 16 + 9) * 65 + n]);   o1.y = pk2(T[(kq * 16 + 10) * 65 + n], T[(kq * 16 + 11) * 65 + n]);
            o1.z = pk2(T[(kq * 16 + 12) * 65 + n], T[(kq * 16 + 13) * 65 + n]); o1.w = pk2(T[(kq * 16 + 14) * 65 + n], T[(kq * 16 + 15) * 65 + n]);
            u16* d = dst + (size_t)(n0 + n) * DM + k0 + kq * 16;
            *(u32x4*)d = o0; *(u32x4*)(d + 8) = o1;
        } else {
            float2* tab = (float2*)(p->ws + WS_ROPE);
            for (int i = tid; i < (it == NITEMS - 1 ? 1024 : 0); i += VT) {
                const int pos = i >> 4, fi = i & 15;
                const float freq = powf(10000.f, -(float)fi / 16.f);
                const float ang = (float)pos * freq;
                float s, c; sincosf(ang, &s, &c);
                tab[i] = make_float2(c, s);
            }
            if (it == NITEMS - 1 && tid < 8) ((unsigned*)(p->ws + WS_CTR))[tid] = 0u;
        }
        __syncthreads();
    }
}

__device__ __forceinline__ void prenorm_phase(PP p) {
    const int tid = opaque_tid(), lane = tid & 63, w = __builtin_amdgcn_readfirstlane(tid >> 6);
    const float* MODW = (const float*)(p->ws + WS_MOD);
    u16* H = (u16*)(p->ws + WS_H);
#pragma unroll 2
    for (int row = blockIdx.x * 8 + w; row < NTOK; row += gridDim.x * 8) {
        const float* xr = row < 8192 ? p->in[I_XP] + (size_t)row * DM : p->in[I_XS] + (size_t)(row - 8192) * DM;
        const int mrow = row < 8192 ? 0 : 1 + ((row - 8192) >> 10);
        const float* md = MODW + (size_t)mrow * 3072;
        float4 v[4]; float ss = 0.f;
#pragma unroll
        for (int j = 0; j < 4; ++j) { v[j] = *(const float4*)(xr + lane * 4 + 256 * j); ss += v[j].x * v[j].x + v[j].y * v[j].y + v[j].z * v[j].z + v[j].w * v[j].w; }
        const float rstd = rsqrtf(wave_sum(ss) * (1.f / DM) + EPS);
#pragma unroll
        for (int j = 0; j < 4; ++j) {
            const int c = lane * 4 + 256 * j;
            const float4 g = *(const float4*)(p->in[I_GPRE] + c), sh = *(const float4*)(md + c), scl = *(const float4*)(md + 1024 + c);
            u32x2 o;
            o.x = pk2(v[j].x * rstd * g.x * (1.f + scl.x) + sh.x, v[j].y * rstd * g.y * (1.f + scl.y) + sh.y);
            o.y = pk2(v[j].z * rstd * g.z * (1.f + scl.z) + sh.z, v[j].w * rstd * g.w * (1.f + scl.w) + sh.w);
            *(u32x2*)(H + (size_t)row * DM + c) = o;
        }
    }
}

__device__ __forceinline__ void final_phase(PP p, int l) {
    const int tid = opaque_tid(), lane = tid & 63, w = __builtin_amdgcn_readfirstlane(tid >> 6);
    const float* MODW = (const float*)(p->ws + WS_MOD);
    const u16* Y = (const u16*)(p->ws + WS_Z);
    u16* H = (u16*)(p->ws + WS_H);
#pragma unroll 2
    for (int row = blockIdx.x * 8 + w; row < NTOK; row += gridDim.x * 8) {
        const float* xr = (l == 0) ? (row < 8192 ? p->in[I_XP] + (size_t)row * DM : p->in[I_XS] + (size_t)(row - 8192) * DM) : p->out + OUT_Y + (size_t)row * DM;
        const int mrow = row < 8192 ? 0 : 1 + ((row - 8192) >> 10);
        const float* md = MODW + (size_t)(l * 9 + mrow) * 3072;
        float4 y[4], x[4]; float ss = 0.f;
#pragma unroll
        for (int j = 0; j < 4; ++j) {
            { const u32x2 yr = *(const u32x2*)(Y + (size_t)row * DM + lane * 4 + 256 * j); y[j] = make_float4(bflo(yr.x), bfhi(yr.x), bflo(yr.y), bfhi(yr.y)); }
            x[j] = *(const float4*)(xr + lane * 4 + 256 * j);
            ss += y[j].x * y[j].x + y[j].y * y[j].y + y[j].z * y[j].z + y[j].w * y[j].w;
        }
        const float rstd = rsqrtf(wave_sum(ss) * (1.f / DM) + EPS);
        float ss2 = 0.f;
#pragma unroll
        for (int j = 0; j < 4; ++j) {
            const int c = lane * 4 + 256 * j;
            const float4 g = *(const float4*)(p->in[I_GPOST] + l * DM + c), gt = *(const float4*)(md + 2048 + c);
            x[j].x += gt.x * (y[j].x * rstd * g.x); x[j].y += gt.y * (y[j].y * rstd * g.y); x[j].z += gt.z * (y[j].z * rstd * g.z); x[j].w += gt.w * (y[j].w * rstd * g.w);
            *(float4*)(p->out + OUT_Y + (size_t)row * DM + c) = x[j];
            ss2 += x[j].x * x[j].x + x[j].y * x[j].y + x[j].z * x[j].z + x[j].w * x[j].w;
        }
        if (l == 0) {
            const float rstd2 = rsqrtf(wave_sum(ss2) * (1.f / DM) + EPS);
            const float* md1 = MODW + (size_t)(9 + mrow) * 3072;
#pragma unroll
            for (int j = 0; j < 4; ++j) {
                const int c = lane * 4 + 256 * j;
                const float4 g = *(const float4*)(p->in[I_GPRE] + DM + c), sh = *(const float4*)(md1 + c), scl = *(const float4*)(md1 + 1024 + c);
                u32x2 o;
                o.x = pk2(x[j].x * rstd2 * g.x * (1.f + scl.x) + sh.x, x[j].y * rstd2 * g.y * (1.f + scl.y) + sh.y);
                o.y = pk2(x[j].z * rstd2 * g.z * (1.f + scl.z) + sh.z, x[j].w * rstd2 * g.w * (1.f + scl.w) + sh.w);
                *(u32x2*)(H + (size_t)row * DM + c) = o;
            }
        }
    }
}

typedef __attribute__((address_space(3))) unsigned* lds_u32p;
__device__ __forceinline__ void dma16(const void* g, void* l) { __builtin_amdgcn_global_load_lds((const unsigned*)g, (lds_u32p)l, 16, 0, 0); }

__device__ __forceinline__ void gemm_phase(const u16* __restrict__ A, const u16* __restrict__ BT, int ntn, u16* __restrict__ C, int ldc, int tail16, unsigned char* smem) {
    const int tid = opaque_tid(), lane = tid & 63, w = __builtin_amdgcn_readfirstlane(tid >> 6), wm = w >> 2, wn = w & 3, fr = lane & 15, quad = lane >> 4;
    const int lrow = tid >> 3, lch = tid & 7, gch = lch ^ ((lrow >> 1) & 7);
    unsigned char* As = smem;
    unsigned char* Bs = smem + 65536;
    const int xcd = blockIdx.x & 7, jloc = blockIdx.x >> 3, nloc = gridDim.x >> 3, per_x = 8 * ntn;
    for (int tl = jloc; tl < per_x; tl += nloc) {
        const int mt_ = xcd * 8 + (tl & 7), nt_ = tl >> 3, m0 = mt_ * 256, n0 = nt_ * 256;
        const u16* gA = A + (size_t)(m0 + lrow) * DM + gch * 8;
        const u16* gB = BT + (size_t)(n0 + lrow) * DM + gch * 8;
        f32x4 acc[8][4];
#pragma unroll
        for (int i = 0; i < 8; ++i)
#pragma unroll
            for (int j = 0; j < 4; ++j) acc[i][j] = (f32x4){0.f, 0.f, 0.f, 0.f};
#pragma unroll
        for (int i = 0; i < 4; ++i) { dma16(gA + (size_t)i * 64 * DM, As + i * 8192 + tid * 16); dma16(gB + (size_t)i * 64 * DM, Bs + i * 8192 + tid * 16); }
        __syncthreads();
        for (int kt = 0; kt < 16; ++kt) {
            const int buf = kt & 1;
            if (kt < 15) {
#pragma unroll
                for (int i = 0; i < 4; ++i) {
                    dma16(gA + (size_t)i * 64 * DM + (kt + 1) * 64, As + (buf ^ 1) * 32768 + i * 8192 + tid * 16);
                    dma16(gB + (size_t)i * 64 * DM + (kt + 1) * 64, Bs + (buf ^ 1) * 32768 + i * 8192 + tid * 16);
                }
            }
            const unsigned char* Ab = As + buf * 32768; const unsigned char* Bb = Bs + buf * 32768;
#pragma unroll
            for (int ks = 0; ks < 2; ++ks) {
                bf16x8 bfr[4];
#pragma unroll
                for (int j = 0; j < 4; ++j) bfr[j] = *(const bf16x8*)(Bb + swz(wn * 64 + j * 16 + fr, ks * 4 + quad));
#pragma unroll
                for (int ih = 0; ih < 2; ++ih) {
                    bf16x8 af[4];
#pragma unroll
                    for (int i = 0; i < 4; ++i) af[i] = *(const bf16x8*)(Ab + swz(wm * 128 + (ih * 4 + i) * 16 + fr, ks * 4 + quad));
#pragma unroll
                    for (int i = 0; i < 4; ++i)
#pragma unroll
                        for (int j = 0; j < 4; ++j) acc[ih * 4 + i][j] = mfma16(bfr[j], af[i], acc[ih * 4 + i][j]);
                }
            }
            __syncthreads();
        }
#pragma unroll
        for (int i = 0; i < 8; ++i)
#pragma unroll
            for (int jp = 0; jp < 2; ++jp) {
                const unsigned ax = pk2(acc[i][2 * jp][0], acc[i][2 * jp][1]), ay = pk2(acc[i][2 * jp][2], acc[i][2 * jp][3]);
                const unsigned bx = pk2(acc[i][2 * jp + 1][0], acc[i][2 * jp + 1][1]), by = pk2(acc[i][2 * jp + 1][2], acc[i][2 * jp + 1][3]);
                const auto sx = __builtin_amdgcn_permlane16_swap(ax, bx, false, false);
                const auto sy = __builtin_amdgcn_permlane16_swap(ay, by, false, false);
                const int row = m0 + wm * 128 + i * 16 + fr;
                const int col = n0 + wn * 64 + ((quad & 1) ? (2 * jp + 1) * 16 + (quad - 1) * 4 : (2 * jp) * 16 + quad * 4);
                *(u32x4*)(C + (size_t)row * ldc + col) = (u32x4){sx[0], sy[0], sx[1], sy[1]};
            }
    }
    if (tail16 > 0) {
        const int ntask = 1024 * tail16;
        for (int task = blockIdx.x * 8 + w; task < ntask; task += gridDim.x * 8) {
            const int mt16 = task / tail16, nt16 = task % tail16, col0 = ntn * 256 + nt16 * 16;
            const u16* ap = A + (size_t)(mt16 * 16 + fr) * DM + quad * 8;
            const u16* bp = BT + (size_t)(col0 + fr) * DM + quad * 8;
            f32x4 acc = (f32x4){0.f, 0.f, 0.f, 0.f};
#pragma unroll 8
            for (int ks = 0; ks < 32; ++ks) acc = mfma16(*(const bf16x8*)(bp + ks * 32), *(const bf16x8*)(ap + ks * 32), acc);
            u32x2 o; o.x = pk2(acc[0], acc[1]); o.y = pk2(acc[2], acc[3]);
            *(u32x2*)(C + (size_t)(mt16 * 16 + fr) * ldc + col0 + quad * 4) = o;
        }
    }
}

__device__ __forceinline__ float log_sigmoid_f(float x) { return fminf(x, 0.f) - __logf(1.f + __expf(-fabsf(x))); }
__device__ __forceinline__ void unpack8(u32x4 r, float (&v)[8]) {
    v[0] = bflo(r.x); v[1] = bfhi(r.x); v[2] = bflo(r.y); v[3] = bfhi(r.y); v[4] = bflo(r.z); v[5] = bfhi(r.z); v[6] = bflo(r.w); v[7] = bfhi(r.w);
}
__device__ __forceinline__ u32x4 pack8(const float (&v)[8]) { u32x4 o; o.x = pk2(v[0], v[1]); o.y = pk2(v[2], v[3]); o.z = pk2(v[4], v[5]); o.w = pk2(v[6], v[7]); return o; }
__device__ __forceinline__ void store8f(float* d, const float (&v)[8]) { *(float4*)d = make_float4(v[0], v[1], v[2], v[3]); *(float4*)(d + 4) = make_float4(v[4], v[5], v[6], v[7]); }
__device__ __forceinline__ void vt_store(u16* Tl, u32x4 raw, int tok_l, int sub, u16* vt_base, int rowlen, int tcol0) {
    const int tid = vtid();
    Tl[(sub * 8 + 0) * 40 + tok_l] = (u16)(raw.x & 0xffff); Tl[(sub * 8 + 1) * 40 + tok_l] = (u16)(raw.x >> 16);
    Tl[(sub * 8 + 2) * 40 + tok_l] = (u16)(raw.y & 0xffff); Tl[(sub * 8 + 3) * 40 + tok_l] = (u16)(raw.y >> 16);
    Tl[(sub * 8 + 4) * 40 + tok_l] = (u16)(raw.z & 0xffff); Tl[(sub * 8 + 5) * 40 + tok_l] = (u16)(raw.z >> 16);
    Tl[(sub * 8 + 6) * 40 + tok_l] = (u16)(raw.w & 0xffff); Tl[(sub * 8 + 7) * 40 + tok_l] = (u16)(raw.w >> 16);
    __syncthreads();
    const int d = tid >> 2, part = tid & 3;
    const u32x4 o = *(const u32x4*)(Tl + d * 40 + part * 8);
    *(u32x4*)(vt_base + (size_t)d * rowlen + tcol0 + part * 8) = o;
    __syncthreads();
}

__device__ void post_phase(PP p, int l, unsigned char* smem) {
    const int tid = vtid(), tok_l = tid >> 3, sub = tid & 7, hb = half_id();
    u16* Tl = (u16*)smem;
    u16* Z = (u16*)(p->ws + WS_Z);
    u16* KA = (u16*)(p->ws + WS_KA); u16* VAT = (u16*)(p->ws + WS_VAT);
    u16* KB = (u16*)(p->ws + WS_KB); u16* VBT = (u16*)(p->ws + WS_VBT); u16* CVT = (u16*)(p->ws + WS_CVT);
    const float2* tab = (const float2*)(smem + 8192);
    const float* gwL = (const float*)(smem + 16384);
    const float* gbL = (const float*)(smem + 32768);
    {
        const float2* tabg = (const float2*)(p->ws + WS_ROPE);
        for (int i = tid; i < 1024; i += VT) ((float2*)(smem + 8192))[i] = tabg[i];
        for (int i = tid; i < 4096; i += VT) ((float*)(smem + 16384))[i] = ((i >> 11) ? p->in[I_CWB] : p->in[I_CWF])[l * 2048 + (i & 2047)];
        if (tid < 256) ((float*)(smem + 32768))[tid] = ((tid >> 7) ? p->in[I_CBB] : p->in[I_CBF])[l * 128 + (tid & 127)];
    }
    float gq[8], gk[8];
#pragma unroll
    for (int i = 0; i < 8; ++i) { gq[i] = p->in[I_AQG][l * 64 + sub * 8 + i]; gk[i] = p->in[I_AKG][l * 64 + sub * 8 + i]; }
    __syncthreads();
    for (int it0 = blockIdx.x * 2; it0 < 512 + 768; it0 += gridDim.x * 2) {
        const int it = it0 + hb;
        asm volatile("" : "+s"(p));
        if (it < 512) {
            const int tok0 = it * 32, grp = tok0 >= 8192;
            const int b = grp ? (tok0 - 8192) >> 10 : tok0 >> 8, t0 = grp ? (tok0 - 8192) & 1023 : tok0 & 255;
            const int tok = tok0 + tok_l, t = t0 + tok_l;
            const int Lk = grp ? 1280 : 256, kof = grp ? 256 : 0;
            const int prow = t >> 6, pcol = t & 63;
            u32x4 raw_next = *(const u32x4*)(Z + (size_t)tok * NIN + sub * 8);
            for (int u = 0; u < 28; ++u) {
                const int col0 = u < 24 ? u * 64 : 1792 + (u - 24) * 64;
                u16* zp = Z + (size_t)tok * NIN + col0 + sub * 8;
                u32x4 raw = raw_next;
                if (u + 1 < 28) { const int coln = (u + 1) < 24 ? (u + 1) * 64 : 1792 + (u + 1 - 24) * 64; raw_next = *(const u32x4*)(Z + (size_t)tok * NIN + coln + sub * 8); }
                if (u < 10) {
                    float v[8]; unpack8(raw, v);
                    float ss = 0.f;
#pragma unroll
                    for (int i = 0; i < 8; ++i) ss += v[i] * v[i];
                    ss = sum8(ss);
                    const float rstd = rsqrtf(ss * (1.f / 64.f) + EPS);
#pragma unroll
                    for (int i = 0; i < 8; ++i) v[i] = v[i] * rstd * (u < 8 ? gq[i] : gk[i]);
                    if (u >= 8 && !grp) store8f(p->out + OUT_AK + ((size_t)((b * 2 + l) * 2 + (u - 8)) * 256 + t) * 64 + sub * 8, v);
                    if (grp) {
                        const int pos = (sub & 4) ? pcol : prow;
#pragma unroll
                        for (int i = 0; i < 8; ++i) {
                            const float pr = xor2f(v[i]);
                            const float2 cs = tab[pos * 16 + (sub & 1) * 8 + i];
                            v[i] = (sub & 2) ? v[i] * cs.x + pr * cs.y : v[i] * cs.x - pr * cs.y;
                        }
                    }
                    const u32x4 o = pack8(v);
                    if (u < 8) *(u32x4*)zp = o;
                    else *(u32x4*)(KA + kv_off(grp, b, u - 8, 2, 1280) + (size_t)(kof + t) * 64 + sub * 8) = o;
                } else if (u < 12) {
                    const int kvh = u - 10;
                    if (!grp) { float v[8]; unpack8(raw, v); store8f(p->out + OUT_AV + ((size_t)((b * 2 + l) * 2 + kvh) * 256 + t) * 64 + sub * 8, v); }
                    vt_store(Tl, raw, tok_l, sub, VAT + kv_off(grp, b, kvh, 2, 1280), Lk, kof + t0);
                } else if (u < 20) {
                    const int isk = u >= 16, h = isk ? u - 16 : u - 12;
                    float v[8]; unpack8(raw, v);
                    if (isk && !grp) store8f(p->out + OUT_BK + ((size_t)((b * 2 + l) * 4 + h) * 256 + t) * 64 + sub * 8, v);
                    if (grp) {
                        const int pos = (sub & 2) ? pcol : prow;
#pragma unroll
                        for (int i = 0; i < 8; ++i) {
                            const float pr = xor1f(v[i]);
                            const float2 cs = tab[pos * 16 + 2 * i];
                            v[i] = (sub & 1) ? v[i] * cs.x + pr * cs.y : v[i] * cs.x - pr * cs.y;
                        }
                        raw = pack8(v);
                    }
                    if (!isk) { if (grp) *(u32x4*)zp = raw; }
                    else *(u32x4*)(KB + kv_off(grp, b, h, 4, 1280) + (size_t)(kof + t) * 64 + sub * 8) = raw;
                } else if (u < 24) {
                    const int h = u - 20;
                    if (!grp) { float v[8]; unpack8(raw, v); store8f(p->out + OUT_BV + ((size_t)((b * 2 + l) * 4 + h) * 256 + t) * 64 + sub * 8, v); }
                    vt_store(Tl, raw, tok_l, sub, VBT + kv_off(grp, b, h, 4, 1280), Lk, kof + t0);
                } else {
                    const int h = u - 24;
                    vt_store(Tl, raw, tok_l, sub, CVT + kv_off(grp, b, h, 4, 1024), grp ? 1024 : 256, t0);
                }
            }
            {
                const int dir = sub >> 2, c0 = (sub & 3) * 32;
                float lr[16];
                { float t8[8];
                  unpack8(*(const u32x4*)(Z + (size_t)tok * NIN + 2048 + dir * 16), t8);
#pragma unroll
                  for (int i = 0; i < 8; ++i) lr[i] = t8[i];
                  unpack8(*(const u32x4*)(Z + (size_t)tok * NIN + 2048 + dir * 16 + 8), t8);
#pragma unroll
                  for (int i = 0; i < 8; ++i) lr[8 + i] = t8[i]; }
                const float* gw = gwL + dir * 2048 + c0;
                const float* gb = gbL + dir * 128 + c0;
                float* gout = (float*)(p->ws + WS_G) + (size_t)tok * 256 + dir * 128 + c0;
#pragma unroll 1
                for (int cc = 0; cc < 8; ++cc) {
                    float4 a = *(const float4*)(gb + cc * 4);
#pragma unroll
                    for (int r = 0; r < 16; ++r) { const float4 w4 = *(const float4*)(gw + r * 128 + cc * 4); a.x += lr[r] * w4.x; a.y += lr[r] * w4.y; a.z += lr[r] * w4.z; a.w += lr[r] * w4.w; }
                    a.x = log_sigmoid_f(a.x) * (1.f / 16.f); a.y = log_sigmoid_f(a.y) * (1.f / 16.f); a.z = log_sigmoid_f(a.z) * (1.f / 16.f); a.w = log_sigmoid_f(a.w) * (1.f / 16.f);
                    *(float4*)(gout + cc * 4) = a;
                }
            }
        } else {
            const int idx = it - 512, cu = idx % 12, rest = idx / 12, ktile = rest & 7, b = rest >> 3;
            const int key0 = ktile * 32, key = key0 + tok_l;
            const float* src; int hh, H;
            if (cu < 2) { hh = cu; H = 2; src = p->in[I_CAK]; } else if (cu < 4) { hh = cu - 2; H = 2; src = p->in[I_CAV]; }
            else if (cu < 8) { hh = cu - 4; H = 4; src = p->in[I_CBK]; } else { hh = cu - 8; H = 4; src = p->in[I_CBV]; }
            const float* sp = src + ((size_t)((b * 2 + l) * H + hh) * 256 + key) * 64 + sub * 8;
            const float4 a0 = *(const float4*)sp, a1 = *(const float4*)(sp + 4);
            u32x4 o; o.x = pk2(a0.x, a0.y); o.y = pk2(a0.z, a0.w); o.z = pk2(a1.x, a1.y); o.w = pk2(a1.z, a1.w);
            if (cu < 2) *(u32x4*)(KA + kv_off(1, b, hh, 2, 1280) + (size_t)key * 64 + sub * 8) = o;
            else if (cu < 4) vt_store(Tl, o, tok_l, sub, VAT + kv_off(1, b, hh, 2, 1280), 1280, key0);
            else if (cu < 8) *(u32x4*)(KB + kv_off(1, b, hh, 4, 1280) + (size_t)key * 64 + sub * 8) = o;
            else vt_store(Tl, o, tok_l, sub, VBT + kv_off(1, b, hh, 4, 1280), 1280, key0);
        }
    }
}

__device__ __forceinline__ float quad_max(float v) {
    unsigned u = __float_as_uint(v);
    auto r = __builtin_amdgcn_permlane16_swap(u, u, false, false);
    v = fmaxf(__uint_as_float(r[0]), __uint_as_float(r[1]));
    u = __float_as_uint(v);
    auto r2 = __builtin_amdgcn_permlane32_swap(u, u, false, false);
    return fmaxf(__uint_as_float(r2[0]), __uint_as_float(r2[1]));
}

template <int NP>
__device__ __forceinline__ void attn_sweep(const u16* __restrict__ Kg, const u16* __restrict__ Vg, int Lk, const bf16x8 (&qf)[2][2], unsigned char* smem, f32x4 (&O)[NP][4][2]) {
    const int tid = vtid(), lane = tid & 63, fr = lane & 15, quad = lane >> 4;
    float mrun[NP][2], lrun[NP][2];
#pragma unroll
    for (int pp = 0; pp < NP; ++pp)
#pragma unroll
        for (int qs = 0; qs < 2; ++qs) {
            mrun[pp][qs] = -INFINITY; lrun[pp][qs] = 0.f;
#pragma unroll
            for (int dt = 0; dt < 4; ++dt) O[pp][dt][qs] = (f32x4){0.f, 0.f, 0.f, 0.f};
        }
    unsigned char* Ks = smem;
    unsigned char* Vs = smem + 16384;
    const int t512 = opaque_tid(), lrow = t512 >> 3, lch = t512 & 7;
    u32x4 rk, rv;
    rk = *(const u32x4*)(Kg + (size_t)lrow * 64 + lch * 8); rv = *(const u32x4*)(Vg + (size_t)lrow * Lk + lch * 8);
    *(u32x4*)(Ks + swz(lrow, lch)) = rk; *(u32x4*)(Vs + swz(lrow, lch)) = rv;
    __syncthreads();
    const int ntile = Lk >> 6;
    for (int t = 0; t < ntile; ++t) {
        const int buf = t & 1;
        if (t + 1 < ntile) {
            rk = *(const u32x4*)(Kg + (size_t)((t + 1) * 64 + lrow) * 64 + lch * 8);
            rv = *(const u32x4*)(Vg + (size_t)lrow * Lk + (t + 1) * 64 + lch * 8);
        }
        const unsigned char* Kb = Ks + buf * 8192; const unsigned char* Vb = Vs + buf * 8192;
#pragma unroll
        for (int pp = 0; pp < NP; ++pp) {
            f32x4 S[4][2];
#pragma unroll
            for (int kt = 0; kt < 4; ++kt) { S[kt][0] = (f32x4){0.f, 0.f, 0.f, 0.f}; S[kt][1] = (f32x4){0.f, 0.f, 0.f, 0.f}; }
#pragma unroll
            for (int kt = 0; kt < 4; ++kt)
#pragma unroll
                for (int ks = (NP == 2 ? pp : 0); ks < (NP == 2 ? pp + 1 : 2); ++ks) {
                    const bf16x8 kf = *(const bf16x8*)(Kb + swz(kt * 16 + fr, ks * 4 + quad));
                    S[kt][0] = mfma16(kf, qf[0][ks], S[kt][0]);
                    S[kt][1] = mfma16(kf, qf[1][ks], S[kt][1]);
                }
            bf16x8 pf[2][2];
#pragma unroll
            for (int qs = 0; qs < 2; ++qs) {
                float mx = -INFINITY;
#pragma unroll
                for (int kt = 0; kt < 4; ++kt)
#pragma unroll
                    for (int r = 0; r < 4; ++r) mx = fmaxf(mx, S[kt][qs][r]);
                mx = quad_max(mx);
                const float mold = mrun[pp][qs];
                const float mnew = fmaxf(mold, mx);
                mrun[pp][qs] = mnew;
                const f32x4 mv = (f32x4){mnew, mnew, mnew, mnew};
                f32x4 ps4 = (f32x4){0.f, 0.f, 0.f, 0.f};
#pragma unroll
                for (int kt = 0; kt < 4; ++kt) {
                    const f32x4 d = S[kt][qs] - mv;
                    f32x4 e; e[0] = fast_exp2(d[0]); e[1] = fast_exp2(d[1]); e[2] = fast_exp2(d[2]); e[3] = fast_exp2(d[3]);
                    S[kt][qs] = e; ps4 += e;
                }
                const float ps = (ps4[0] + ps4[1]) + (ps4[2] + ps4[3]);
                if (__builtin_amdgcn_ballot_w64(mnew != mold) != 0ull) {
                    const float alpha = fast_exp2(mold - mnew);
                    lrun[pp][qs] = lrun[pp][qs] * alpha + ps;
#pragma unroll
                    for (int dt = 0; dt < 4; ++dt) O[pp][dt][qs] *= alpha;
                } else {
                    lrun[pp][qs] += ps;
                }
#pragma unroll
                for (int kb = 0; kb < 2; ++kb) {
                    u32x4 pk; pk.x = pk2(S[2 * kb][qs][0], S[2 * kb][qs][1]); pk.y = pk2(S[2 * kb][qs][2], S[2 * kb][qs][3]);
                    pk.z = pk2(S[2 * kb + 1][qs][0], S[2 * kb + 1][qs][1]); pk.w = pk2(S[2 * kb + 1][qs][2], S[2 * kb + 1][qs][3]);
                    pf[qs][kb] = as_bf8(pk);
                }
            }
#pragma unroll
            for (int dt = 0; dt < 4; ++dt)
#pragma unroll
                for (int kb = 0; kb < 2; ++kb) {
                    const int row = dt * 16 + fr;
                    const u32x2 v0 = *(const u32x2*)(Vb + swz(row, kb * 4 + (quad >> 1)) + (quad & 1) * 8);
                    const u32x2 v1 = *(const u32x2*)(Vb + swz(row, kb * 4 + 2 + (quad >> 1)) + (quad & 1) * 8);
                    const bf16x8 vf = as_bf8((u32x4){v0.x, v0.y, v1.x, v1.y});
                    O[pp][dt][0] = mfma16(vf, pf[0][kb], O[pp][dt][0]);
                    O[pp][dt][1] = mfma16(vf, pf[1][kb], O[pp][dt][1]);
                }
        }
        if (t + 1 < ntile) { *(u32x4*)(Ks + (buf ^ 1) * 8192 + swz(lrow, lch)) = rk; *(u32x4*)(Vs + (buf ^ 1) * 8192 + swz(lrow, lch)) = rv; }
        __syncthreads();
    }
#pragma unroll
    for (int pp = 0; pp < NP; ++pp)
#pragma unroll
        for (int qs = 0; qs < 2; ++qs) {
            float lt = rows_sum(lrun[pp][qs]);
            const float inv = __builtin_amdgcn_rcpf(lt);
#pragma unroll
            for (int dt = 0; dt < 4; ++dt) O[pp][dt][qs] *= inv;
        }
}

template <int MODE>
__device__ void attn_item(PP p, int l, int grp, int b, int head, int qb, unsigned char* smem_blk) {
    const int tid = vtid(), lane = tid & 63, w = __builtin_amdgcn_readfirstlane(tid >> 6), fr = lane & 15, quad = lane >> 4;
    const int Lk = grp ? 1280 : 256;
    const int tokbase = grp ? 8192 + b * 1024 : b * 256;
    const u16* Z = (const u16*)(p->ws + WS_Z);
    u16* MIX = (u16*)(p->ws + WS_MIX);
    const int qcol = MODE ? 768 + head * 64 : head * 64;
    const int mcol = MODE ? 512 + head * 64 : head * 64;
    const u16* Kg = MODE ? (const u16*)(p->ws + WS_KB) + kv_off(grp, b, head, 4, 1280) : (const u16*)(p->ws + WS_KA) + kv_off(grp, b, head >> 2, 2, 1280);
    const u16* Vg = MODE ? (const u16*)(p->ws + WS_VBT) + kv_off(grp, b, head, 4, 1280) : (const u16*)(p->ws + WS_VAT) + kv_off(grp, b, head >> 2, 2, 1280);
    const float cscale = (MODE ? 0.17677669529663687f : 0.125f) * 1.4426950408889634f;

    bf16x8 qf[2][2];
#pragma unroll
    for (int qs = 0; qs < 2; ++qs)
#pragma unroll
        for (int ks = 0; ks < 2; ++ks)
            {
                const u32x4 raw = *(const u32x4*)(Z + (size_t)(tokbase + qb * 128 + w * 32 + qs * 16 + fr) * NIN + qcol + ks * 32 + quad * 8);
                float qv[8]; unpack8(raw, qv);
#pragma unroll
                for (int i = 0; i < 8; ++i) qv[i] *= cscale;
                qf[qs][ks] = as_bf8(pack8(qv));
            }

    f32x4 O[4][2];
    float lam = 0.f, lam_init = 0.f;
    if (MODE == 0) {
        f32x4 O1[1][4][2];
        attn_sweep<1>(Kg, Vg, Lk, qf, smem_blk, O1);
#pragma unroll
        for (int dt = 0; dt < 4; ++dt) { O[dt][0] = O1[0][dt][0]; O[dt][1] = O1[0][dt][1]; }
    } else {
        f32x4 O2[2][4][2];
        attn_sweep<2>(Kg, Vg, Lk, qf, smem_blk, O2);
        float s1 = 0.f, s2 = 0.f;
        for (int i = 0; i < 32; ++i) { s1 += p->in[I_LQ1][l * 32 + i] * p->in[I_LK1][l * 32 + i]; s2 += p->in[I_LQ2][l * 32 + i] * p->in[I_LK2][l * 32 + i]; }
        lam_init = 0.8f - 0.6f * expf(-0.3f * (float)l);
        lam = expf(s1) - expf(s2) + lam_init;
#pragma unroll
        for (int dt = 0; dt < 4; ++dt) { O[dt][0] = O2[0][dt][0] - lam * O2[1][dt][0]; O[dt][1] = O2[0][dt][1] - lam * O2[1][dt][1]; }
    }
#pragma unroll
    for (int qs = 0; qs < 2; ++qs) {
        const int tok = tokbase + qb * 128 + w * 32 + qs * 16 + fr;
        if (MODE == 1) {
            float ss = 0.f;
#pragma unroll
            for (int dt = 0; dt < 4; ++dt)
#pragma unroll
                for (int r = 0; r < 4; ++r) ss += O[dt][qs][r] * O[dt][qs][r];
            ss = rows_sum(ss);
            const float rstd = rsqrtf(ss * (1.f / 64.f) + EPS) * (1.f - lam_init);
#pragma unroll
            for (int dt = 0; dt < 4; ++dt) {
                const f32x4 g4 = *(const f32x4*)(p->in[I_BOG] + l * 64 + dt * 16 + quad * 4);
                O[dt][qs] *= g4 * rstd;
            }
        }
#pragma unroll
        for (int dp = 0; dp < 2; ++dp) {
            unsigned ox[2], oy[2];
#pragma unroll
            for (int k = 0; k < 2; ++k) {
                const int dt = 2 * dp + k, col = mcol + dt * 16 + quad * 4;
                const u32x2 ur = *(const u32x2*)(Z + (size_t)tok * NIN + 2080 + col);
                ox[k] = pk2(O[dt][qs][0] * silu_f(bflo(ur.x)), O[dt][qs][1] * silu_f(bfhi(ur.x)));
                oy[k] = pk2(O[dt][qs][2] * silu_f(bflo(ur.y)), O[dt][qs][3] * silu_f(bfhi(ur.y)));
            }
            const auto sx = __builtin_amdgcn_permlane16_swap(ox[0], ox[1], false, false);
            const auto sy = __builtin_amdgcn_permlane16_swap(oy[0], oy[1], false, false);
            const int scol = mcol + ((quad & 1) ? (2 * dp + 1) * 16 + (quad - 1) * 4 : (2 * dp) * 16 + quad * 4);
            *(u32x4*)(MIX + (size_t)tok * DM + scol) = (u32x4){sx[0], sy[0], sx[1], sy[1]};
        }
    }
    __syncthreads();
}


__device__ void gla_item(PP p, int l, int grp, int b, int h, int dir, unsigned char* smem) {
    const int tid = vtid(), lane = tid & 63, w = __builtin_amdgcn_readfirstlane(tid >> 6), fr = lane & 15, quad = lane >> 4;
    const int L = grp ? 1024 : 256, nch = L >> 6;
    const int tokbase = grp ? 8192 + b * 1024 : b * 256;
    const u16* Z = (const u16*)(p->ws + WS_Z);
    u16* MIX = (u16*)(p->ws + WS_MIX);
    float* OC = (float*)(p->ws + (dir ? WS_H : WS_OC));
    const u16* Vt = (const u16*)(p->ws + WS_CVT) + kv_off(grp, b, h, 4, 1024);
    u16* QtL = (u16*)smem;
    u16* KtL = (u16*)(smem + 5120);
    u16* KlT = (u16*)(smem + 10240);
    float* Dl = (float*)(smem + 14848);
    const float qscale = 0.17677669529663687f;

    {
        f32x4 Sacc[2][4];
        const float* s0 = (dir ? p->in[I_SCB] : p->in[I_SCF]) + (size_t)((b * 2 + l) * 4 + h) * 32 * 64;
#pragma unroll
        for (int dt = 0; dt < 2; ++dt)
#pragma unroll
            for (int et = 0; et < 4; ++et)
#pragma unroll
                for (int r = 0; r < 4; ++r) Sacc[dt][et][r] = grp ? s0[(dt * 16 + quad * 4 + r) * 64 + et * 16 + fr] : 0.f;
        float4 ng0, ng1; u32x4 nq, nk;
        {
            const int c0 = dir ? nch - 1 : 0;
            const float* gp = (const float*)(p->ws + WS_G) + (size_t)(tokbase + c0 * 64 + lane) * 256 + dir * 128 + h * 32 + 8 * w;
            ng0 = *(const float4*)gp; ng1 = *(const float4*)(gp + 4);
            const size_t zrow = (size_t)(tokbase + c0 * 64 + lane) * NIN;
            nq = *(const u32x4*)(Z + zrow + 1536 + h * 32 + 8 * w); nk = *(const u32x4*)(Z + zrow + 1664 + h * 32 + 8 * w);
        }
        for (int ci = 0; ci < nch; ++ci) {
            const int c = dir ? nch - 1 - ci : ci, t0 = c * 64;
            const float4 g0 = ng0, g1 = ng1; const u32x4 cq = nq, ck = nk;
            bf16x8 vfr[4][2];
#pragma unroll
            for (int et = 0; et < 4; ++et)
#pragma unroll
                for (int jb = 0; jb < 2; ++jb) {
                    const u16* vp = Vt + (size_t)(et * 16 + fr) * L + t0 + jb * 32 + quad * 4;
                    const u32x2 a = *(const u32x2*)vp, a2 = *(const u32x2*)(vp + 16);
                    vfr[et][jb] = as_bf8((u32x4){a.x, a.y, a2.x, a2.y});
                }
            if (ci + 1 < nch) {
                const int cn = dir ? nch - 2 - ci : ci + 1;
                const float* gp = (const float*)(p->ws + WS_G) + (size_t)(tokbase + cn * 64 + lane) * 256 + dir * 128 + h * 32 + 8 * w;
                ng0 = *(const float4*)gp; ng1 = *(const float4*)(gp + 4);
                const size_t zrow = (size_t)(tokbase + cn * 64 + lane) * NIN;
                nq = *(const u32x4*)(Z + zrow + 1536 + h * 32 + 8 * w); nk = *(const u32x4*)(Z + zrow + 1664 + h * 32 + 8 * w);
            }
            {
                float q[8], k[8], g[8], pre[8];
                g[0] = g0.x; g[1] = g0.y; g[2] = g0.z; g[3] = g0.w; g[4] = g1.x; g[5] = g1.y; g[6] = g1.z; g[7] = g1.w;
#pragma unroll
                for (int dd = 0; dd < 8; ++dd) pre[dd] = g[dd];
                unpack8(cq, q);
                unpack8(ck, k);
#pragma unroll
                for (int off = 1; off < 64; off <<= 1)
#pragma unroll
                    for (int dd = 0; dd < 8; ++dd) { const float tv = __shfl_up(pre[dd], off); if (lane >= off) pre[dd] += tv; }
                float qt[8], kt8[8];
#pragma unroll
                for (int dd = 0; dd < 8; ++dd) {
                    const float tot = __shfl(pre[dd], 63);
                    const float cum = dir ? (tot - pre[dd] + g[dd]) : pre[dd];
                    qt[dd] = q[dd] * qscale * __expf(cum);
                    kt8[dd] = k[dd] * __expf(-cum);
                    const float kl = k[dd] * __expf(tot - cum);
                    KlT[(8 * w + dd) * 72 + lane] = (u16)(pk2(kl, 0.f) & 0xffff);
                    if (lane == 0) Dl[8 * w + dd] = __expf(tot);
                }
                *(u32x4*)(QtL + lane * 40 + 8 * w) = pack8(qt);
                *(u32x4*)(KtL + lane * 40 + 8 * w) = pack8(kt8);
            }
            __syncthreads();
            const bf16x8 qstd = *(const bf16x8*)(QtL + (16 * w + fr) * 40 + quad * 8);
            f32x4 PT[4];
#pragma unroll
            for (int jt = 0; jt < 4; ++jt) {
                PT[jt] = (f32x4){0.f, 0.f, 0.f, 0.f};
                const bool need = dir ? (jt >= w) : (jt <= w);
                if (need) {
                    const bf16x8 kfr = *(const bf16x8*)(KtL + (jt * 16 + fr) * 40 + quad * 8);
                    PT[jt] = mfma16(kfr, qstd, PT[jt]);
                    if (jt == w) {
#pragma unroll
                        for (int r = 0; r < 4; ++r) { const int jj = quad * 4 + r; const bool keep = dir ? (jj >= fr) : (jj <= fr); if (!keep) PT[jt][r] = 0.f; }
                    }
                }
            }
            bf16x8 pa[2];
#pragma unroll
            for (int jb = 0; jb < 2; ++jb) {
                u32x4 pk; pk.x = pk2(PT[2 * jb][0], PT[2 * jb][1]); pk.y = pk2(PT[2 * jb][2], PT[2 * jb][3]);
                pk.z = pk2(PT[2 * jb + 1][0], PT[2 * jb + 1][1]); pk.w = pk2(PT[2 * jb + 1][2], PT[2 * jb + 1][3]);
                pa[jb] = as_bf8(pk);
            }
            bf16x8 qrel;
            {
                const u32x2 a = *(const u32x2*)(QtL + (16 * w + fr) * 40 + quad * 4), a2 = *(const u32x2*)(QtL + (16 * w + fr) * 40 + 16 + quad * 4);
                qrel = as_bf8((u32x4){a.x, a.y, a2.x, a2.y});
            }
            f32x4 Oacc[4];
#pragma unroll
            for (int et = 0; et < 4; ++et) {
                Oacc[et] = (f32x4){0.f, 0.f, 0.f, 0.f};
                Oacc[et] = mfma16(pa[0], vfr[et][0], Oacc[et]);
                Oacc[et] = mfma16(pa[1], vfr[et][1], Oacc[et]);
                u32x4 sb; sb.x = pk2(Sacc[0][et][0], Sacc[0][et][1]); sb.y = pk2(Sacc[0][et][2], Sacc[0][et][3]);
                sb.z = pk2(Sacc[1][et][0], Sacc[1][et][1]); sb.w = pk2(Sacc[1][et][2], Sacc[1][et][3]);
                Oacc[et] = mfma16(qrel, as_bf8(sb), Oacc[et]);
            }
#pragma unroll
            for (int dt = 0; dt < 2; ++dt) {
                bf16x8 klf[2];
#pragma unroll
                for (int jb = 0; jb < 2; ++jb) {
                    const u32x2 a = *(const u32x2*)(KlT + (dt * 16 + fr) * 72 + jb * 32 + quad * 4), a2 = *(const u32x2*)(KlT + (dt * 16 + fr) * 72 + jb * 32 + 16 + quad * 4);
                    klf[jb] = as_bf8((u32x4){a.x, a.y, a2.x, a2.y});
                }
                float dec[4];
#pragma unroll
                for (int r = 0; r < 4; ++r) dec[r] = Dl[dt * 16 + quad * 4 + r];
#pragma unroll
                for (int et = 0; et < 4; ++et) {
                    f32x4 hacc;
#pragma unroll
                    for (int r = 0; r < 4; ++r) hacc[r] = dec[r] * Sacc[dt][et][r];
                    hacc = mfma16(klf[0], vfr[et][0], hacc);
                    hacc = mfma16(klf[1], vfr[et][1], hacc);
                    Sacc[dt][et] = hacc;
                }
            }
#pragma unroll
            for (int r = 0; r < 4; ++r) {
                const int tok = tokbase + t0 + 16 * w + quad * 4 + r;
                float* ocp = OC + (size_t)tok * 256 + h * 64 + fr;
#pragma unroll
                for (int et = 0; et < 4; ++et) ocp[et * 16] = Oacc[et][r];
            }
            __syncthreads();
        }
        if (!grp && w == 0) {
            float* so = p->out + (dir ? OUT_SB : OUT_SF) + (size_t)((b * 2 + l) * 4 + h) * 32 * 64;
#pragma unroll
            for (int dt = 0; dt < 2; ++dt)
#pragma unroll
                for (int et = 0; et < 4; ++et)
#pragma unroll
                    for (int r = 0; r < 4; ++r) so[(dt * 16 + quad * 4 + r) * 64 + et * 16 + fr] = Sacc[dt][et][r];
        }
        __syncthreads();
    }
}

__device__ __forceinline__ void gla_combine(PP p, int l, int grp, int b, int h) {
    const int tid = opaque_tid(), l16 = tid & 15, rowl = tid >> 4;
    const int L = grp ? 1024 : 256, tokbase = grp ? 8192 + b * 1024 : b * 256;
    const float* OCf = (const float*)(p->ws + WS_OC);
    const float* OCb = (const float*)(p->ws + WS_H);
    const u16* Z = (const u16*)(p->ws + WS_Z);
    u16* MIX = (u16*)(p->ws + WS_MIX);
    const float4 g = *(const float4*)(p->in[I_COG] + l * 64 + l16 * 4);
#pragma unroll 4
    for (int r0 = 0; r0 < L; r0 += 32) {
        const size_t tok = (size_t)(tokbase + r0 + rowl);
        const float4 a = *(const float4*)(OCf + tok * 256 + h * 64 + l16 * 4), c = *(const float4*)(OCb + tok * 256 + h * 64 + l16 * 4);
        const float o0 = a.x + c.x, o1 = a.y + c.y, o2 = a.z + c.z, o3 = a.w + c.w;
        float ss = o0 * o0 + o1 * o1 + o2 * o2 + o3 * o3;
        ss = sum16(ss);
        const float rstd = rsqrtf(ss * (1.f / 64.f) + EPS);
        const u32x2 ur = *(const u32x2*)(Z + tok * NIN + 2080 + 768 + h * 64 + l16 * 4);
        u32x2 ov;
        ov.x = pk2(o0 * rstd * g.x * silu_f(bflo(ur.x)), o1 * rstd * g.y * silu_f(bfhi(ur.x)));
        ov.y = pk2(o2 * rstd * g.z * silu_f(bflo(ur.y)), o3 * rstd * g.w * silu_f(bfhi(ur.y)));
        *(u32x2*)(MIX + tok * DM + 768 + h * 64 + l16 * 4) = ov;
    }
}

__device__ void mix_phase(PP p, int l, int ctr_idx, unsigned char* smem_blk) {
    unsigned* ctr = (unsigned*)(p->ws + WS_CTR) + ctr_idx;
    volatile int* s_item = (volatile int*)(smem_blk + 65024);
    const int hb = half_id();
    unsigned char* smem = smem_blk + hb * 65536;
    for (;;) {
        if (opaque_tid() == 0) *s_item = (int)atomicAdd(ctr, 1u);
        __syncthreads();
        const int pi = __builtin_amdgcn_readfirstlane(*s_item);
        __syncthreads();
#if PROBE_DUP == 1
        if (pi >= 928 + 256) break;
        const int pj = pi < 928 ? pi : pi - 928 + 160;
#elif PROBE_DUP == 2
        if (pi >= 928 + 384) break;
        const int pj = pi < 928 ? pi : pi - 928 + 544;
#elif PROBE_DUP == 3
        if (pi >= 928 + 128) break;
        const int pj = pi < 928 ? pi : pi - 928 + 32;
#else
        if (pi >= 928) break;
        const int pj = pi;
#endif
        const int idx = 2 * pj + hb;
        asm volatile("" : "+s"(p));
        int kind, grp, b, h, qb = 0;
        if (idx < 64) { kind = 0; grp = 1; b = idx >> 3; h = (idx >> 1) & 3; qb = idx & 1; }
        else if (idx < 320) { const int j = idx - 64; kind = 1; grp = 1; b = j >> 5; h = (j >> 3) & 3; qb = j & 7; }
        else if (idx < 832) { const int j = idx - 320; kind = 2; grp = 1; b = j >> 6; h = (j >> 3) & 7; qb = j & 7; }
        else if (idx < 1088) { const int j = idx - 832; kind = 0; grp = 0; b = j >> 3; h = (j >> 1) & 3; qb = j & 1; }
        else if (idx < 1344) { const int j = idx - 1088; kind = 1; grp = 0; b = j >> 3; h = (j >> 1) & 3; qb = j & 1; }
        else { const int j = idx - 1344; kind = 2; grp = 0; b = j >> 4; h = (j >> 1) & 7; qb = j & 1; }
        if (kind == 0) { gla_item(p, l, grp, b, h, qb, smem); gla_combine(p, l, grp, b, h); }
        else if (kind == 1) attn_item<1>(p, l, grp, b, h, qb, smem_blk);
        else attn_item<0>(p, l, grp, b, h, qb, smem_blk);
    }
}

#define XB_TMO      128
#define XB_XCNT(j)  (256  + 64 * (j))
#define XB_XSUB(j)  (1280 + 64 * (j))
#define XB_XGEN(j)  (2304 + 64 * (j))
#define XB_TOP      3328
#define XB_TOPGEN   3392
#define XCD_BAR_WORDS 3456
#define XB_SPIN_CAP (1u << 18)
#define LAS __attribute__((address_space(3)))

__device__ __forceinline__ unsigned xb_ld(unsigned* p)              { return __hip_atomic_load(p, __ATOMIC_RELAXED, __HIP_MEMORY_SCOPE_AGENT); }
__device__ __forceinline__ unsigned xb_add(unsigned* p, unsigned v) { return __hip_atomic_fetch_add(p, v, __ATOMIC_RELAXED, __HIP_MEMORY_SCOPE_AGENT); }
__device__ __forceinline__ unsigned xb_xcc_id() { return (unsigned)__builtin_amdgcn_s_getreg((3 << 11) | 20) & 0xFu; }
#define XB_SPIN(cond, bar) do { unsigned _sp = 0; while (cond) { __builtin_amdgcn_s_sleep(1); \
    if ((++_sp & 255u) == 0u) { if (xb_ld(&(bar)[XB_TMO])) break; if (_sp > XB_SPIN_CAP) { atomicAdd(&(bar)[XB_TMO], 1u); break; } } } } while (0)

struct XcdBarrier {
    unsigned* bar; unsigned x;
    volatile LAS unsigned* st;
};

__device__ __forceinline__ XcdBarrier xcd_barrier_post(unsigned* bar, volatile LAS unsigned* st) {
    XcdBarrier b; b.bar = bar; b.x = xb_xcc_id(); b.st = st;
    if (threadIdx.x == 0) (void)xb_add(&bar[XB_XCNT(b.x)], 1u);
    return b;
}
__device__ __forceinline__ void xcd_barrier_complete(unsigned* bar, unsigned x, unsigned& nloc, unsigned& nx) {
    const unsigned G = gridDim.x * gridDim.y * gridDim.z;
    unsigned sum, cnt, mine, sp = 0u;
    for (;;) {
        sum = 0u; cnt = 0u; mine = 0u;
#pragma unroll
        for (unsigned j = 0; j < 16; ++j) { const unsigned c = xb_ld(&bar[XB_XCNT(j)]); sum += c; cnt += (c > 0u) ? 1u : 0u; mine = (j == x) ? c : mine; }
        if (sum == G) break;
        __builtin_amdgcn_s_sleep(1);
        if ((++sp & 255u) == 0u) { if (xb_ld(&bar[XB_TMO])) break; if (sp > XB_SPIN_CAP) { atomicAdd(&bar[XB_TMO], 1u); break; } }
    }
    nloc = mine > 0u ? mine : 1u; nx = cnt > 0u ? cnt : 1u;
}

__device__ __forceinline__ void xcd_barrier(const XcdBarrier& b) {
    asm volatile("s_waitcnt vmcnt(0)" ::: "memory");
    __syncthreads();
    if (threadIdx.x == 0) {
        unsigned* bar = b.bar;
        __builtin_amdgcn_s_waitcnt(0);
        unsigned nloc = b.st[0], nx = b.st[1];
        if (nloc == 0u) { xcd_barrier_complete(bar, b.x, nloc, nx); b.st[0] = nloc; b.st[1] = nx; }
        const unsigned old = xb_add(&bar[XB_XSUB(b.x)], 1u);
        const unsigned gen = old / nloc;
        if (old + 1u == (gen + 1u) * nloc) {
            __builtin_amdgcn_fence(__ATOMIC_RELEASE, "agent");
            asm volatile("s_waitcnt vmcnt(0)" ::: "memory");
            const unsigned og = xb_add(&bar[XB_TOP], 1u);
            const unsigned tg = og / nx;
            if (og + 1u == (tg + 1u) * nx) xb_add(&bar[XB_TOPGEN], 1u);
            else XB_SPIN(xb_ld(&bar[XB_TOPGEN]) == tg, bar);
            __builtin_amdgcn_fence(__ATOMIC_ACQUIRE, "agent");
            xb_add(&bar[XB_XGEN(b.x)], 1u);
            asm volatile("s_waitcnt vmcnt(0)" ::: "memory");
        } else {
            XB_SPIN(xb_ld(&bar[XB_XGEN(b.x)]) == gen, bar);
            __builtin_amdgcn_fence(__ATOMIC_ACQUIRE, "agent");
            asm volatile("s_waitcnt vmcnt(0)" ::: "memory");
        }
    }
    __syncthreads();
}


__global__ void __launch_bounds__(NTHREADS, 1) mega_fwd(Params p_unused, int ph_lo, int ph_hi) {
    extern __shared__ __attribute__((aligned(16))) unsigned char smem[];
    __shared__ uint4 xb_words;
    if (threadIdx.x == 0) xb_words = make_uint4(0u, 0u, 0u, 0u);
    __syncthreads();
    const XcdBarrier xb = xcd_barrier_post((unsigned*)(((PP)__builtin_amdgcn_kernarg_segment_ptr())->ws + WS_BAR), (volatile LAS unsigned*)&xb_words);
    unsigned char* const smem_h = smem + half_id() * 65536;
    for (int ph = ph_lo; ph < ph_hi; ++ph) {
        PP p = (PP)__builtin_amdgcn_kernarg_segment_ptr();
        asm volatile("" : "+s"(p));
        for (int rep = 0; rep < (((PROBE_MASK >> ph) & 1) ? 2 : 1); ++rep) {
            if (rep) xcd_barrier(xb);
            if (ph == 0) prep_phase(p, smem_h);
            else if (ph == 1) prenorm_phase(p);
            else {
                const int l = (ph - 2) / 5, s = (ph - 2) % 5;
                if (s == 0 || s == 3) {
                    const bool inp = (s == 0);
                    gemm_phase((const u16*)(p->ws + (inp ? WS_H : WS_MIX)), inp ? (const u16*)(p->ws + WS_WIN) + (size_t)l * NINP * DM : (const u16*)(p->ws + WS_WOUT) + (size_t)l * DM * DM,
                               inp ? 12 : 4, (u16*)(p->ws + WS_Z), inp ? NIN : DM, inp ? 2 : 0, smem);
                }
                else if (s == 1) post_phase(p, l, smem_h);
                else if (s == 2) mix_phase(p, l, 2 * rep + l, smem);
                else final_phase(p, l);
            }
        }
        if (ph + 1 < ph_hi) { if (ph_hi == 0x7fffffff) cg::this_grid().sync(); else xcd_barrier(xb); }
    }
}

extern "C" void kernel_launch(void* const* d_in, const int* in_sizes, int n_in, void* d_out, int out_size, void* d_ws, size_t ws_size, hipStream_t stream) {
    static int grid = 0;
    if (grid == 0) {
        if (n_in != 28 || ws_size < WS_END) { fprintf(stderr, "kernel_launch: unexpected n_in %d / ws_size %zu (need %zu)\n", n_in, ws_size, (size_t)WS_END); grid = -1; return; }
        int dev = 0, cus = 0, per_cu = 0;
        (void)hipGetDevice(&dev);
        (void)hipDeviceGetAttribute(&cus, hipDeviceAttributeMultiprocessorCount, dev);
        if (hipFuncSetAttribute((const void*)mega_fwd, hipFuncAttributeMaxDynamicSharedMemorySize, 131072) != hipSuccess) fprintf(stderr, "kernel_launch: hipFuncSetAttribute failed\n");
        if (hipOccupancyMaxActiveBlocksPerMultiprocessor(&per_cu, (const void*)mega_fwd, NTHREADS, 131072) != hipSuccess || per_cu < 1) { fprintf(stderr, "kernel_launch: occupancy query failed (%d)\n", per_cu); per_cu = 1; }
        if (per_cu > 1) per_cu = 1;
        grid = cus * per_cu;
        fprintf(stderr, "kernel_launch: cus %d per_cu %d grid %d\n", cus, per_cu, grid);
    }
    if (grid < 0) return;
    (void)hipMemsetAsync((unsigned char*)d_ws + WS_BAR, 0, 3456 * 4, stream);
    Params p{};
    for (int i = 0; i < 28; ++i) p.in[i] = (const float*)d_in[i];
    p.out = (float*)d_out; p.ws = (unsigned char*)d_ws;
#if N_LAUNCH_SPLIT
    for (int ph = 0; ph < 12; ++ph) hipLaunchKernelGGL(mega_fwd, dim3(grid), dim3(NTHREADS), 131072, stream, p, ph, ph + 1);
#else
    int lo = 0, hi = 12;
    void* args[] = {&p, &lo, &hi};
    hipError_t e = hipLaunchCooperativeKernel((const void*)mega_fwd, dim3(grid), dim3(NTHREADS), args, 131072, stream);
    if (e != hipSuccess) fprintf(stderr, "cooperative launch failed: %s (grid %d)\n", hipGetErrorString(e), grid);
#endif
}
```

```cpp
#include <hip/hip_runtime.h>
#include <hip/hip_cooperative_groups.h>
#include <cstdio>
#include <cstdint>
namespace cg = cooperative_groups;

typedef unsigned short u16;
typedef short bf16x8 __attribute__((ext_vector_type(8)));
typedef float f32x4 __attribute__((ext_vector_type(4)));
typedef unsigned u32x4 __attribute__((ext_vector_type(4)));
typedef unsigned u32x2 __attribute__((ext_vector_type(2)));

#ifndef PROBE_MASK
#define PROBE_MASK 0
#endif
#ifndef PROBE_DUP
#define PROBE_DUP 0
#endif
#define N_LAUNCH_SPLIT 0

constexpr int NTOK = 16384, DM = 1024, NIN = 3104, NINP = 3200;
constexpr int NTHREADS = 512;
constexpr int VT = 256;
constexpr float EPS = 1e-6f;

constexpr size_t WS_WIN  = 0;
constexpr size_t WS_WOUT = WS_WIN  + (size_t)2 * NINP * DM * 2;
constexpr size_t WS_MOD  = WS_WOUT + (size_t)2 * DM * DM * 2;
constexpr size_t WS_ROPE = WS_MOD  + (size_t)2 * 9 * 3072 * 4;
constexpr size_t WS_CTR  = WS_ROPE + 64 * 16 * 8;
constexpr size_t WS_H    = WS_CTR  + 256;
constexpr size_t WS_Z    = WS_H    + (size_t)NTOK * DM * 2;
constexpr size_t WS_MIX  = WS_Z    + (size_t)NTOK * NIN * 2;
constexpr size_t WS_KA   = WS_MIX  + (size_t)NTOK * DM * 2;
constexpr size_t KA_ELEMS = (size_t)(32 * 2 * 256 + 8 * 2 * 1280) * 64;
constexpr size_t KB_ELEMS = (size_t)(32 * 4 * 256 + 8 * 4 * 1280) * 64;
constexpr size_t CV_ELEMS = (size_t)(32 * 4 * 256 + 8 * 4 * 1024) * 64;
constexpr size_t WS_VAT  = WS_KA  + KA_ELEMS * 2;
constexpr size_t WS_KB   = WS_VAT + KA_ELEMS * 2;
constexpr size_t WS_VBT  = WS_KB  + KB_ELEMS * 2;
constexpr size_t WS_CVT  = WS_VBT + KB_ELEMS * 2;
constexpr size_t WS_OC   = WS_CVT + CV_ELEMS * 2;
constexpr size_t WS_G    = WS_OC  + (size_t)NTOK * 256 * 4;
constexpr size_t WS_BAR  = WS_G   + (size_t)NTOK * 256 * 4;
constexpr size_t WS_END  = WS_BAR + 3456 * 4;

constexpr size_t OUT_Y   = 0;
constexpr size_t OUT_AK  = 16777216;
constexpr size_t OUT_AV  = OUT_AK + 2097152;
constexpr size_t OUT_BK  = OUT_AV + 2097152;
constexpr size_t OUT_BV  = OUT_BK + 4194304;
constexpr size_t OUT_SF  = OUT_BV + 4194304;
constexpr size_t OUT_SB  = OUT_SF + 524288;

struct Params {
    const float* in[28];
    float* out;
    unsigned char* ws;
};
typedef const __attribute__((address_space(4))) Params* PP;
enum { I_XP = 0, I_XS, I_C, I_CAK, I_CAV, I_CBK, I_CBV, I_SCF, I_SCB, I_CCTX, I_WMOD, I_BMOD, I_GPRE, I_GPOST, I_WIN, I_WOUT,
       I_AQG, I_AKG, I_LQ1, I_LK1, I_LQ2, I_LK2, I_BOG, I_CWF, I_CBF, I_CWB, I_CBB, I_COG };

__device__ __forceinline__ int opaque_tid() { int t = threadIdx.x; asm volatile("" : "+v"(t)); return t; }
__device__ __forceinline__ int vtid() { return opaque_tid() & 255; }
__device__ __forceinline__ int half_id() { return __builtin_amdgcn_readfirstlane(threadIdx.x >> 8); }
typedef __bf16 bf16x2_t __attribute__((ext_vector_type(2)));
typedef float f32x2_t __attribute__((ext_vector_type(2)));
__device__ __forceinline__ unsigned pk2(float lo, float hi) { const f32x2_t v = {lo, hi}; return __builtin_bit_cast(unsigned, __builtin_convertvector(v, bf16x2_t)); }
__device__ __forceinline__ float bflo(unsigned w) { return __uint_as_float(w << 16); }
__device__ __forceinline__ float bfhi(unsigned w) { return __uint_as_float(w & 0xffff0000u); }
__device__ __forceinline__ float fast_exp2(float x) { return __builtin_amdgcn_exp2f(x); }
__device__ __forceinline__ float silu_f(float v) { return v * __builtin_amdgcn_rcpf(1.f + __expf(-v)); }
template <int CTRL> __device__ __forceinline__ float dppf(float v) { return __int_as_float(__builtin_amdgcn_mov_dpp(__float_as_int(v), CTRL, 0xf, 0xf, true)); }
__device__ __forceinline__ float xor1f(float v) { return dppf<0xB1>(v); }
__device__ __forceinline__ float xor2f(float v) { return dppf<0x4E>(v); }
__device__ __forceinline__ float sum8(float v) { v += xor1f(v); v += xor2f(v); v += dppf<0x141>(v); return v; }
__device__ __forceinline__ float sum16(float v) { v = sum8(v); v += dppf<0x140>(v); return v; }
__device__ __forceinline__ float rows_sum(float v) {
    unsigned u = __float_as_uint(v);
    auto r = __builtin_amdgcn_permlane16_swap(u, u, false, false);
    v = __uint_as_float(r[0]) + __uint_as_float(r[1]);
    u = __float_as_uint(v);
    auto r2 = __builtin_amdgcn_permlane32_swap(u, u, false, false);
    return __uint_as_float(r2[0]) + __uint_as_float(r2[1]);
}
__device__ __forceinline__ float wave_sum(float v) { return rows_sum(sum16(v)); }
__device__ __forceinline__ f32x4 mfma16(bf16x8 a, bf16x8 b, f32x4 c) { return __builtin_amdgcn_mfma_f32_16x16x32_bf16(a, b, c, 0, 0, 0); }
__device__ __forceinline__ bf16x8 as_bf8(u32x4 v) { return __builtin_bit_cast(bf16x8, v); }
__device__ __forceinline__ int swz(int row, int chunk) { return row * 128 + ((chunk ^ ((row >> 1) & 7)) << 4); }
__device__ __forceinline__ size_t kv_off(int grp, int b, int h, int H, int LS) {
    return grp ? ((size_t)32 * H * 256 + (size_t)(b * H + h) * LS) * 64 : (size_t)(b * H + h) * 256 * 64;
}

__device__ void prep_phase(PP p, unsigned char* smem) {
    const int tid = vtid(), lane = tid & 63, w = __builtin_amdgcn_readfirstlane(tid >> 6), hb = half_id();
    constexpr int NMOD = 192, NT_IN = 16 * 50, NT_OUT = 16 * 16;
    constexpr int NITEMS = NMOD + 2 * (NT_IN + NT_OUT) + 1;
    float* MODW = (float*)(p->ws + WS_MOD);
    for (int it0 = blockIdx.x * 2; it0 < NITEMS + 1; it0 += gridDim.x * 2) {
        const int it = it0 + hb;
        asm volatile("" : "+s"(p));
        if (it < NMOD) {
            const int l = it / 96, cgp = it % 96;
            float* red = (float*)smem;
            const int cq = tid & 7, kg = tid >> 3;
            const float* wp = p->in[I_WMOD] + (size_t)l * 1024 * 3072 + cgp * 32 + cq * 4;
            const float* cc = p->in[I_C]; const float* cx = p->in[I_CCTX];
            float acc[9][4];
#pragma unroll
            for (int r = 0; r < 9; ++r) { acc[r][0] = 0.f; acc[r][1] = 0.f; acc[r][2] = 0.f; acc[r][3] = 0.f; }
#pragma unroll 4
            for (int kk = 0; kk < 32; ++kk) {
                const int k = kg * 32 + kk;
                const float4 w4 = *(const float4*)(wp + (size_t)k * 3072);
                float cv[9];
                cv[0] = cx[k];
#pragma unroll
                for (int r = 1; r < 9; ++r) cv[r] = cc[(r - 1) * 1024 + k];
#pragma unroll
                for (int r = 0; r < 9; ++r) { const float s = cv[r] * __builtin_amdgcn_rcpf(1.f + __expf(-cv[r])); acc[r][0] += s * w4.x; acc[r][1] += s * w4.y; acc[r][2] += s * w4.z; acc[r][3] += s * w4.w; }
            }
#pragma unroll
            for (int r = 0; r < 9; ++r)
#pragma unroll
                for (int j = 0; j < 4; ++j) { float v = acc[r][j]; v += dppf<0x128>(v); v = rows_sum(v); acc[r][j] = v; }
            if ((lane >> 3) == 0) {
#pragma unroll
                for (int r = 0; r < 9; ++r)
#pragma unroll
                    for (int j = 0; j < 4; ++j) red[(w * 9 + r) * 32 + cq * 4 + j] = acc[r][j];
            }
            __syncthreads();
            for (int i = tid; i < 288; i += VT) {
                const int r = i >> 5, c = i & 31;
                const float v = red[(0 * 9 + r) * 32 + c] + red[(1 * 9 + r) * 32 + c] + red[(2 * 9 + r) * 32 + c] + red[(3 * 9 + r) * 32 + c] + p->in[I_BMOD][l * 3072 + cgp * 32 + c];
                MODW[(size_t)(l * 9 + r) * 3072 + cgp * 32 + c] = v;
            }
        } else if (it < NITEMS - 1) {
            int r = it - NMOD;
            const float* src; u16* dst; int N, NT;
            if (r < 2 * NT_IN) { const int l = r / NT_IN; r %= NT_IN; src = p->in[I_WIN] + (size_t)l * 1024 * NIN; dst = (u16*)(p->ws + WS_WIN) + (size_t)l * NINP * DM; N = NIN; NT = 50; }
            else { r -= 2 * NT_IN; const int l = r / NT_OUT; r %= NT_OUT; src = p->in[I_WOUT] + (size_t)l * 1024 * 1024; dst = (u16*)(p->ws + WS_WOUT) + (size_t)l * DM * DM; N = 1024; NT = 16; }
            const int kt = r / NT, nt = r % NT, k0 = kt * 64, n0 = nt * 64;
            float* T = (float*)smem;
#pragma unroll
            for (int i = 0; i < 4; ++i) {
                const int rr = (tid >> 4) + 16 * i, c = (tid & 15) * 4;
                float4 v = make_float4(0.f, 0.f, 0.f, 0.f);
                if (n0 + c < N) v = *(const float4*)(src + (size_t)(k0 + rr) * N + n0 + c);
                T[rr * 65 + c] = v.x; T[rr * 65 + c + 1] = v.y; T[rr * 65 + c + 2] = v.z; T[rr * 65 + c + 3] = v.w;
            }
            __syncthreads();
            const int n = tid >> 2, kq = tid & 3;
            u32x4 o0, o1;
            o0.x = pk2(T[(kq * 16 + 0) * 65 + n], T[(kq * 16 + 1) * 65 + n]);   o0.y = pk2(T[(kq * 16 + 2) * 65 + n], T[(kq * 16 + 3) * 65 + n]);
            o0.z = pk2(T[(kq * 16 + 4) * 65 + n], T[(kq * 16 + 5) * 65 + n]);   o0.w = pk2(T[(kq * 16 + 6) * 65 + n], T[(kq * 16 + 7) * 65 + n]);
            o1.x = pk2(T[(kq * 16 + 8) * 65 + n], T[(kq * 16 + 9) * 65 + n]);   o1.y = pk2(T[(kq * 16 + 10) * 65 + n], T[(kq * 16 + 11) * 65 + n]);
            o1.z = pk2(T[(kq * 16 + 12) * 65 + n], T[(kq * 16 + 13) * 65 + n]); o1.w = pk2(T[(kq * 16 + 14) * 65 + n], T[(kq * 16 + 15) * 65 + n]);
            u16* d = dst + (size_t)(n0 + n) * DM + k0 + kq * 16;
            *(u32x4*)d = o0; *(u32x4*)(d + 8) = o1;
        } else {
            float2* tab = (float2*)(p->ws + WS_ROPE);
            for (int i = tid; i < (it == NITEMS - 1 ? 1024 : 0); i += VT) {
                const int pos = i >> 4, fi = i & 15;
                const float freq = powf(10000.f, -(float)fi / 16.f);
                const float ang = (float)pos * freq;
                float s, c; sincosf(ang, &s, &c);
                tab[i] = make_float2(c, s);
            }
            if (it == NITEMS - 1 && tid < 8) ((unsigned*)(p->ws + WS_CTR))[tid] = 0u;
        }
        __syncthreads();
    }
}

__device__ __forceinline__ void prenorm_phase(PP p) {
    const int tid = opaque_tid(), lane = tid & 63, w = __builtin_amdgcn_readfirstlane(tid >> 6);
    const float* MODW = (const float*)(p->ws + WS_MOD);
    u16* H = (u16*)(p->ws + WS_H);
#pragma unroll 2
    for (int row = blockIdx.x * 8 + w; row < NTOK; row += gridDim.x * 8) {
        const float* xr = row < 8192 ? p->in[I_XP] + (size_t)row * DM : p->in[I_XS] + (size_t)(row - 8192) * DM;
        const int mrow = row < 8192 ? 0 : 1 + ((row - 8192) >> 10);
        const float* md = MODW + (size_t)mrow * 3072;
        float4 v[4]; float ss = 0.f;
#pragma unroll
        for (int j = 0; j < 4; ++j) { v[j] = *(const float4*)(xr + lane * 4 + 256 * j); ss += v[j].x * v[j].x + v[j].y * v[j].y + v[j].z * v[j].z + v[j].w * v[j].w; }
        const float rstd = rsqrtf(wave_sum(ss) * (1.f / DM) + EPS);
#pragma unroll
        for (int j = 0; j < 4; ++j) {
            const int c = lane * 4 + 256 * j;
            const float4 g = *(const float4*)(p->in[I_GPRE] + c), sh = *(const float4*)(md + c), scl = *(const float4*)(md + 1024 + c);
            u32x2 o;
            o.x = pk2(v[j].x * rstd * g.x * (1.f + scl.x) + sh.x, v[j].y * rstd * g.y * (1.f + scl.y) + sh.y);
            o.y = pk2(v[j].z * rstd * g.z * (1.f + scl.z) + sh.z, v[j].w * rstd * g.w * (1.f + scl.w) + sh.w);
            *(u32x2*)(H + (size_t)row * DM + c) = o;
        }
    }
}

__device__ __forceinline__ void final_phase(PP p, int l) {
    const int tid = opaque_tid(), lane = tid & 63, w = __builtin_amdgcn_readfirstlane(tid >> 6);
    const float* MODW = (const float*)(p->ws + WS_MOD);
    const u16* Y = (const u16*)(p->ws + WS_Z);
    u16* H = (u16*)(p->ws + WS_H);
#pragma unroll 2
    for (int row = blockIdx.x * 8 + w; row < NTOK; row += gridDim.x * 8) {
        const float* xr = (l == 0) ? (row < 8192 ? p->in[I_XP] + (size_t)row * DM : p->in[I_XS] + (size_t)(row - 8192) * DM) : p->out + OUT_Y + (size_t)row * DM;
        const int mrow = row < 8192 ? 0 : 1 + ((row - 8192) >> 10);
        const float* md = MODW + (size_t)(l * 9 + mrow) * 3072;
        float4 y[4], x[4]; float ss = 0.f;
#pragma unroll
        for (int j = 0; j < 4; ++j) {
            { const u32x2 yr = *(const u32x2*)(Y + (size_t)row * DM + lane * 4 + 256 * j); y[j] = make_float4(bflo(yr.x), bfhi(yr.x), bflo(yr.y), bfhi(yr.y)); }
            x[j] = *(const float4*)(xr + lane * 4 + 256 * j);
            ss += y[j].x * y[j].x + y[j].y * y[j].y + y[j].z * y[j].z + y[j].w * y[j].w;
        }
        const float rstd = rsqrtf(wave_sum(ss) * (1.f / DM) + EPS);
        float ss2 = 0.f;
#pragma unroll
        for (int j = 0; j < 4; ++j) {
            const int c = lane * 4 + 256 * j;
            const float4 g = *(const float4*)(p->in[I_GPOST] + l * DM + c), gt = *(const float4*)(md + 2048 + c);
            x[j].x += gt.x * (y[j].x * rstd * g.x); x[j].y += gt.y * (y[j].y * rstd * g.y); x[j].z += gt.z * (y[j].z * rstd * g.z); x[j].w += gt.w * (y[j].w * rstd * g.w);
            *(float4*)(p->out + OUT_Y + (size_t)row * DM + c) = x[j];
            ss2 += x[j].x * x[j].x + x[j].y * x[j].y + x[j].z * x[j].z + x[j].w * x[j].w;
        }
        if (l == 0) {
            const float rstd2 = rsqrtf(wave_sum(ss2) * (1.f / DM) + EPS);
            const float* md1 = MODW + (size_t)(9 + mrow) * 3072;
#pragma unroll
            for (int j = 0; j < 4; ++j) {
                const int c = lane * 4 + 256 * j;
                const float4 g = *(const float4*)(p->in[I_GPRE] + DM + c), sh = *(const float4*)(md1 + c), scl = *(const float4*)(md1 + 1024 + c);
                u32x2 o;
                o.x = pk2(x[j].x * rstd2 * g.x * (1.f + scl.x) + sh.x, x[j].y * rstd2 * g.y * (1.f + scl.y) + sh.y);
                o.y = pk2(x[j].z * rstd2 * g.z * (1.f + scl.z) + sh.z, x[j].w * rstd2 * g.w * (1.f + scl.w) + sh.w);
                *(u32x2*)(H + (size_t)row * DM + c) = o;
            }
        }
    }
}

typedef __attribute__((address_space(3))) unsigned* lds_u32p;
__device__ __forceinline__ void dma16(const void* g, void* l) { __builtin_amdgcn_global_load_lds((const unsigned*)g, (lds_u32p)l, 16, 0, 0); }

__device__ __forceinline__ void gemm_phase(const u16* __restrict__ A, const u16* __restrict__ BT, int ntn, u16* __restrict__ C, int ldc, int tail16, unsigned char* smem) {
    const int tid = opaque_tid(), lane = tid & 63, w = __builtin_amdgcn_readfirstlane(tid >> 6), wm = w >> 2, wn = w & 3, fr = lane & 15, quad = lane >> 4;
    const int lrow = tid >> 3, lch = tid & 7, gch = lch ^ ((lrow >> 1) & 7);
    unsigned char* As = smem;
    unsigned char* Bs = smem + 65536;
    const int xcd = blockIdx.x & 7, jloc = blockIdx.x >> 3, nloc = gridDim.x >> 3, per_x = 8 * ntn;
    for (int tl = jloc; tl < per_x; tl += nloc) {
        const int mt_ = xcd * 8 + (tl & 7), nt_ = tl >> 3, m0 = mt_ * 256, n0 = nt_ * 256;
        const u16* gA = A + (size_t)(m0 + lrow) * DM + gch * 8;
        const u16* gB = BT + (size_t)(n0 + lrow) * DM + gch * 8;
        f32x4 acc[8][4];
#pragma unroll
        for (int i = 0; i < 8; ++i)
#pragma unroll
            for (int j = 0; j < 4; ++j) acc[i][j] = (f32x4){0.f, 0.f, 0.f, 0.f};
#pragma unroll
        for (int i = 0; i < 4; ++i) { dma16(gA + (size_t)i * 64 * DM, As + i * 8192 + tid * 16); dma16(gB + (size_t)i * 64 * DM, Bs + i * 8192 + tid * 16); }
        __syncthreads();
        for (int kt = 0; kt < 16; ++kt) {
            const int buf = kt & 1;
            if (kt < 15) {
#pragma unroll
                for (int i = 0; i < 4; ++i) {
                    dma16(gA + (size_t)i * 64 * DM + (kt + 1) * 64, As + (buf ^ 1) * 32768 + i * 8192 + tid * 16);
                    dma16(gB + (size_t)i * 64 * DM + (kt + 1) * 64, Bs + (buf ^ 1) * 32768 + i * 8192 + tid * 16);
                }
            }
            const unsigned char* Ab = As + buf * 32768; const unsigned char* Bb = Bs + buf * 32768;
#pragma unroll
            for (int ks = 0; ks < 2; ++ks) {
                bf16x8 bfr[4];
#pragma unroll
                for (int j = 0; j < 4; ++j) bfr[j] = *(const bf16x8*)(Bb + swz(wn * 64 + j * 16 + fr, ks * 4 + quad));
#pragma unroll
                for (int ih = 0; ih < 2; ++ih) {
                    bf16x8 af[4];
#pragma unroll
                    for (int i = 0; i < 4; ++i) af[i] = *(const bf16x8*)(Ab + swz(wm * 128 + (ih * 4 + i) * 16 + fr, ks * 4 + quad));
#pragma unroll
                    for (int i = 0; i < 4; ++i)
#pragma unroll
                        for (int j = 0; j < 4; ++j) acc[ih * 4 + i][j] = mfma16(bfr[j], af[i], acc[ih * 4 + i][j]);
                }
            }
            __syncthreads();
        }
#pragma unroll
        for (int i = 0; i < 8; ++i)
#pragma unroll
            for (int jp = 0; jp < 2; ++jp) {
                const unsigned ax = pk2(acc[i][2 * jp][0], acc[i][2 * jp][1]), ay = pk2(acc[i][2 * jp][2], acc[i][2 * jp][3]);
                const unsigned bx = pk2(acc[i][2 * jp + 1][0], acc[i][2 * jp + 1][1]), by = pk2(acc[i][2 * jp + 1][2], acc[i][2 * jp + 1][3]);
                const auto sx = __builtin_amdgcn_permlane16_swap(ax, bx, false, false);
                const auto sy = __builtin_amdgcn_permlane16_swap(ay, by, false, false);
                const int row = m0 + wm * 128 + i * 16 + fr;
                const int col = n0 + wn * 64 + ((quad & 1) ? (2 * jp + 1) * 16 + (quad - 1) * 4 : (2 * jp) * 16 + quad * 4);
                *(u32x4*)(C + (size_t)row * ldc + col) = (u32x4){sx[0], sy[0], sx[1], sy[1]};
            }
    }
    if (tail16 > 0) {
        const int ntask = 1024 * tail16;
        for (int task = blockIdx.x * 8 + w; task < ntask; task += gridDim.x * 8) {
            const int mt16 = task / tail16, nt16 = task % tail16, col0 = ntn * 256 + nt16 * 16;
            const u16* ap = A + (size_t)(mt16 * 16 + fr) * DM + quad * 8;
            const u16* bp = BT + (size_t)(col0 + fr) * DM + quad * 8;
            f32x4 acc = (f32x4){0.f, 0.f, 0.f, 0.f};
#pragma unroll 8
            for (int ks = 0; ks < 32; ++ks) acc = mfma16(*(const bf16x8*)(bp + ks * 32), *(const bf16x8*)(ap + ks * 32), acc);
            u32x2 o; o.x = pk2(acc[0], acc[1]); o.y = pk2(acc[2], acc[3]);
            *(u32x2*)(C + (size_t)(mt16 * 16 + fr) * ldc + col0 + quad * 4) = o;
        }
    }
}

__device__ __forceinline__ float log_sigmoid_f(float x) { return fminf(x, 0.f) - __logf(1.f + __expf(-fabsf(x))); }
__device__ __forceinline__ void unpack8(u32x4 r, float (&v)[8]) {
    v[0] = bflo(r.x); v[1] = bfhi(r.x); v[2] = bflo(r.y); v[3] = bfhi(r.y); v[4] = bflo(r.z); v[5] = bfhi(r.z); v[6] = bflo(r.w); v[7] = bfhi(r.w);
}
__device__ __forceinline__ u32x4 pack8(const float (&v)[8]) { u32x4 o; o.x = pk2(v[0], v[1]); o.y = pk2(v[2], v[3]); o.z = pk2(v[4], v[5]); o.w = pk2(v[6], v[7]); return o; }
__device__ __forceinline__ void store8f(float* d, const float (&v)[8]) { *(float4*)d = make_float4(v[0], v[1], v[2], v[3]); *(float4*)(d + 4) = make_float4(v[4], v[5], v[6], v[7]); }
__device__ __forceinline__ void vt_store(u16* Tl, u32x4 raw, int tok_l, int sub, u16* vt_base, int rowlen, int tcol0) {
    const int tid = vtid();
    Tl[(sub * 8 + 0) * 40 + tok_l] = (u16)(raw.x & 0xffff); Tl[(sub * 8 + 1) * 40 + tok_l] = (u16)(raw.x >> 16);
    Tl[(sub * 8 + 2) * 40 + tok_l] = (u16)(raw.y & 0xffff); Tl[(sub * 8 + 3) * 40 + tok_l] = (u16)(raw.y >> 16);
    Tl[(sub * 8 + 4) * 40 + tok_l] = (u16)(raw.z & 0xffff); Tl[(sub * 8 + 5) * 40 + tok_l] = (u16)(raw.z >> 16);
    Tl[(sub * 8 + 6) * 40 + tok_l] = (u16)(raw.w & 0xffff); Tl[(sub * 8 + 7) * 40 + tok_l] = (u16)(raw.w >> 16);
    __syncthreads();
    const int d = tid >> 2, part = tid & 3;
    const u32x4 o = *(const u32x4*)(Tl + d * 40 + part * 8);
    *(u32x4*)(vt_base + (size_t)d * rowlen + tcol0 + part * 8) = o;
    __syncthreads();
}

__device__ void post_phase(PP p, int l, unsigned char* smem) {
    const int tid = vtid(), tok_l = tid >> 3, sub = tid & 7, hb = half_id();
    u16* Tl = (u16*)smem;
    u16* Z = (u16*)(p->ws + WS_Z);
    u16* KA = (u16*)(p->ws + WS_KA); u16* VAT = (u16*)(p->ws + WS_VAT);
    u16* KB = (u16*)(p->ws + WS_KB); u16* VBT = (u16*)(p->ws + WS_VBT); u16* CVT = (u16*)(p->ws + WS_CVT);
    const float2* tab = (const float2*)(smem + 8192);
    const float* gwL = (const float*)(smem + 16384);
    const float* gbL = (const float*)(smem + 32768);
    {
        const float2* tabg = (const float2*)(p->ws + WS_ROPE);
        for (int i = tid; i < 1024; i += VT) ((float2*)(smem + 8192))[i] = tabg[i];
        for (int i = tid; i < 4096; i += VT) ((float*)(smem + 16384))[i] = ((i >> 11) ? p->in[I_CWB] : p->in[I_CWF])[l * 2048 + (i & 2047)];
        if (tid < 256) ((float*)(smem + 32768))[tid] = ((tid >> 7) ? p->in[I_CBB] : p->in[I_CBF])[l * 128 + (tid & 127)];
    }
    float gq[8], gk[8];
#pragma unroll
    for (int i = 0; i < 8; ++i) { gq[i] = p->in[I_AQG][l * 64 + sub * 8 + i]; gk[i] = p->in[I_AKG][l * 64 + sub * 8 + i]; }
    __syncthreads();
    for (int it0 = blockIdx.x * 2; it0 < 512 + 768; it0 += gridDim.x * 2) {
        const int it = it0 + hb;
        asm volatile("" : "+s"(p));
        if (it < 512) {
            const int tok0 = it * 32, grp = tok0 >= 8192;
            const int b = grp ? (tok0 - 8192) >> 10 : tok0 >> 8, t0 = grp ? (tok0 - 8192) & 1023 : tok0 & 255;
            const int tok = tok0 + tok_l, t = t0 + tok_l;
            const int Lk = grp ? 1280 : 256, kof = grp ? 256 : 0;
            const int prow = t >> 6, pcol = t & 63;
            u32x4 raw_next = *(const u32x4*)(Z + (size_t)tok * NIN + sub * 8);
            for (int u = 0; u < 28; ++u) {
                const int col0 = u < 24 ? u * 64 : 1792 + (u - 24) * 64;
                u16* zp = Z + (size_t)tok * NIN + col0 + sub * 8;
                u32x4 raw = raw_next;
                if (u + 1 < 28) { const int coln = (u + 1) < 24 ? (u + 1) * 64 : 1792 + (u + 1 - 24) * 64; raw_next = *(const u32x4*)(Z + (size_t)tok * NIN + coln + sub * 8); }
                if (u < 10) {
                    float v[8]; unpack8(raw, v);
                    float ss = 0.f;
#pragma unroll
                    for (int i = 0; i < 8; ++i) ss += v[i] * v[i];
                    ss = sum8(ss);
                    const float rstd = rsqrtf(ss * (1.f / 64.f) + EPS);
#pragma unroll
                    for (int i = 0; i < 8; ++i) v[i] = v[i] * rstd * (u < 8 ? gq[i] : gk[i]);
                    if (u >= 8 && !grp) store8f(p->out + OUT_AK + ((size_t)((b * 2 + l) * 2 + (u - 8)) * 256 + t) * 64 + sub * 8, v);
                    if (grp) {
                        const int pos = (sub & 4) ? pcol : prow;
#pragma unroll
                        for (int i = 0; i < 8; ++i) {
                            const float pr = xor2f(v[i]);
                            const float2 cs = tab[pos * 16 + (sub & 1) * 8 + i];
                            v[i] = (sub & 2) ? v[i] * cs.x + pr * cs.y : v[i] * cs.x - pr * cs.y;
                        }
                    }
                    const u32x4 o = pack8(v);
                    if (u < 8) *(u32x4*)zp = o;
                    else *(u32x4*)(KA + kv_off(grp, b, u - 8, 2, 1280) + (size_t)(kof + t) * 64 + sub * 8) = o;
                } else if (u < 12) {
                    const int kvh = u - 10;
                    if (!grp) { float v[8]; unpack8(raw, v); store8f(p->out + OUT_AV + ((size_t)((b * 2 + l) * 2 + kvh) * 256 + t) * 64 + sub * 8, v); }
                    vt_store(Tl, raw, tok_l, sub, VAT + kv_off(grp, b, kvh, 2, 1280), Lk, kof + t0);
                } else if (u < 20) {
                    const int isk = u >= 16, h = isk ? u - 16 : u - 12;
                    float v[8]; unpack8(raw, v);
                    if (isk && !grp) store8f(p->out + OUT_BK + ((size_t)((b * 2 + l) * 4 + h) * 256 + t) * 64 + sub * 8, v);
                    if (grp) {
                        const int pos = (sub & 2) ? pcol : prow;
#pragma unroll
                        for (int i = 0; i < 8; ++i) {
                            const float pr = xor1f(v[i]);
                            const float2 cs = tab[pos * 16 + 2 * i];
                            v[i] = (sub & 1) ? v[i] * cs.x + pr * cs.y : v[i] * cs.x - pr * cs.y;
                        }
                        raw = pack8(v);
                    }
                    if (!isk) { if (grp) *(u32x4*)zp = raw; }
                    else *(u32x4*)(KB + kv_off(grp, b, h, 4, 1280) + (size_t)(kof + t) * 64 + sub * 8) = raw;
                } else if (u < 24) {
                    const int h = u - 20;
                    if (!grp) { float v[8]; unpack8(raw, v); store8f(p->out + OUT_BV + ((size_t)((b * 2 + l) * 4 + h) * 256 + t) * 64 + sub * 8, v); }
                    vt_store(Tl, raw, tok_l, sub, VBT + kv_off(grp, b, h, 4, 1280), Lk, kof + t0);
                } else {
                    const int h = u - 24;
                    vt_store(Tl, raw, tok_l, sub, CVT + kv_off(grp, b, h, 4, 1024), grp ? 1024 : 256, t0);
                }
            }
            {
                const int dir = sub >> 2, c0 = (sub & 3) * 32;
                float lr[16];
                { float t8[8];
                  unpack8(*(const u32x4*)(Z + (size_t)tok * NIN + 2048 + dir * 16), t8);
#pragma unroll
                  for (int i = 0; i < 8; ++i) lr[i] = t8[i];
                  unpack8(*(const u32x4*)(Z + (size_t)tok * NIN + 2048 + dir * 16 + 8), t8);
#pragma unroll
                  for (int i = 0; i < 8; ++i) lr[8 + i] = t8[i]; }
                const float* gw = gwL + dir * 2048 + c0;
                const float* gb = gbL + dir * 128 + c0;
                float* gout = (float*)(p->ws + WS_G) + (size_t)tok * 256 + dir * 128 + c0;
#pragma unroll 1
                for (int cc = 0; cc < 8; ++cc) {
                    float4 a = *(const float4*)(gb + cc * 4);
#pragma unroll
                    for (int r = 0; r < 16; ++r) { const float4 w4 = *(const float4*)(gw + r * 128 + cc * 4); a.x += lr[r] * w4.x; a.y += lr[r] * w4.y; a.z += lr[r] * w4.z; a.w += lr[r] * w4.w; }
                    a.x = log_sigmoid_f(a.x) * (1.f / 16.f); a.y = log_sigmoid_f(a.y) * (1.f / 16.f); a.z = log_sigmoid_f(a.z) * (1.f / 16.f); a.w = log_sigmoid_f(a.w) * (1.f / 16.f);
                    *(float4*)(gout + cc * 4) = a;
                }
            }
        } else {
            const int idx = it - 512, cu = idx % 12, rest = idx / 12, ktile = rest & 7, b = rest >> 3;
            const int key0 = ktile * 32, key = key0 + tok_l;
            const float* src; int hh, H;
            if (cu < 2) { hh = cu; H = 2; src = p->in[I_CAK]; } else if (cu < 4) { hh = cu - 2; H = 2; src = p->in[I_CAV]; }
            else if (cu < 8) { hh = cu - 4; H = 4; src = p->in[I_CBK]; } else { hh = cu - 8; H = 4; src = p->in[I_CBV]; }
            const float* sp = src + ((size_t)((b * 2 + l) * H + hh) * 256 + key) * 64 + sub * 8;
            const float4 a0 = *(const float4*)sp, a1 = *(const float4*)(sp + 4);
            u32x4 o; o.x = pk2(a0.x, a0.y); o.y = pk2(a0.z, a0.w); o.z = pk2(a1.x, a1.y); o.w = pk2(a1.z, a1.w);
            if (cu < 2) *(u32x4*)(KA + kv_off(1, b, hh, 2, 1280) + (size_t)key * 64 + sub * 8) = o;
            else if (cu < 4) vt_store(Tl, o, tok_l, sub, VAT + kv_off(1, b, hh, 2, 1280), 1280, key0);
            else if (cu < 8) *(u32x4*)(KB + kv_off(1, b, hh, 4, 1280) + (size_t)key * 64 + sub * 8) = o;
            else vt_store(Tl, o, tok_l, sub, VBT + kv_off(1, b, hh, 4, 1280), 1280, key0);
        }
    }
}

__device__ __forceinline__ float quad_max(float v) {
    unsigned u = __float_as_uint(v);
    auto r = __builtin_amdgcn_permlane16_swap(u, u, false, false);
    v = fmaxf(__uint_as_float(r[0]), __uint_as_float(r[1]));
    u = __float_as_uint(v);
    auto r2 = __builtin_amdgcn_permlane32_swap(u, u, false, false);
    return fmaxf(__uint_as_float(r2[0]), __uint_as_float(r2[1]));
}

template <int NP>
__device__ __forceinline__ void attn_sweep(const u16* __restrict__ Kg, const u16* __restrict__ Vg, int Lk, const bf16x8 (&qf)[2][2], unsigned char* smem, f32x4 (&O)[NP][4][2]) {
    const int tid = vtid(), lane = tid & 63, fr = lane & 15, quad = lane >> 4;
    float mrun[NP][2]; f32x4 Lacc[NP][2];
#pragma unroll
    for (int pp = 0; pp < NP; ++pp)
#pragma unroll
        for (int qs = 0; qs < 2; ++qs) {
            mrun[pp][qs] = -INFINITY; Lacc[pp][qs] = (f32x4){0.f, 0.f, 0.f, 0.f};
#pragma unroll
            for (int dt = 0; dt < 4; ++dt) O[pp][dt][qs] = (f32x4){0.f, 0.f, 0.f, 0.f};
        }
    unsigned char* Ks = smem;
    unsigned char* Vs = smem + 16384;
    const int t512 = opaque_tid(), lrow = t512 >> 3, lch = t512 & 7;
    u32x4 rk, rv;
    rk = *(const u32x4*)(Kg + (size_t)lrow * 64 + lch * 8); rv = *(const u32x4*)(Vg + (size_t)lrow * Lk + lch * 8);
    *(u32x4*)(Ks + swz(lrow, lch)) = rk; *(u32x4*)(Vs + swz(lrow, lch)) = rv;
    __syncthreads();
    const int ntile = Lk >> 6;
    for (int t = 0; t < ntile; ++t) {
        const int buf = t & 1;
        if (t + 1 < ntile) {
            rk = *(const u32x4*)(Kg + (size_t)((t + 1) * 64 + lrow) * 64 + lch * 8);
            rv = *(const u32x4*)(Vg + (size_t)lrow * Lk + (t + 1) * 64 + lch * 8);
        }
        const unsigned char* Kb = Ks + buf * 8192; const unsigned char* Vb = Vs + buf * 8192;
#pragma unroll
        for (int pp = 0; pp < NP; ++pp) {
            f32x4 S[4][2];
#pragma unroll
            for (int kt = 0; kt < 4; ++kt) { S[kt][0] = (f32x4){0.f, 0.f, 0.f, 0.f}; S[kt][1] = (f32x4){0.f, 0.f, 0.f, 0.f}; }
#pragma unroll
            for (int kt = 0; kt < 4; ++kt)
#pragma unroll
                for (int ks = (NP == 2 ? pp : 0); ks < (NP == 2 ? pp + 1 : 2); ++ks) {
                    const bf16x8 kf = *(const bf16x8*)(Kb + swz(kt * 16 + fr, ks * 4 + quad));
                    S[kt][0] = mfma16(kf, qf[0][ks], S[kt][0]);
                    S[kt][1] = mfma16(kf, qf[1][ks], S[kt][1]);
                }
            bf16x8 pf[2][2];
#pragma unroll
            for (int qs = 0; qs < 2; ++qs) {
                float mx = -INFINITY;
#pragma unroll
                for (int kt = 0; kt < 4; ++kt)
#pragma unroll
                    for (int r = 0; r < 4; ++r) mx = fmaxf(mx, S[kt][qs][r]);
                mx = quad_max(mx);
                const float mold = mrun[pp][qs];
                const float mnew = fmaxf(mold, mx);
                mrun[pp][qs] = mnew;
                const f32x4 mv = (f32x4){mnew, mnew, mnew, mnew};
#pragma unroll
                for (int kt = 0; kt < 4; ++kt) {
                    const f32x4 d = S[kt][qs] - mv;
                    f32x4 e; e[0] = fast_exp2(d[0]); e[1] = fast_exp2(d[1]); e[2] = fast_exp2(d[2]); e[3] = fast_exp2(d[3]);
                    S[kt][qs] = e;
                }
                if (__builtin_amdgcn_ballot_w64(mnew != mold) != 0ull) {
                    const float alpha = fast_exp2(mold - mnew);
                    Lacc[pp][qs] *= alpha;
#pragma unroll
                    for (int dt = 0; dt < 4; ++dt) O[pp][dt][qs] *= alpha;
                }
#pragma unroll
                for (int kb = 0; kb < 2; ++kb) {
                    u32x4 pk; pk.x = pk2(S[2 * kb][qs][0], S[2 * kb][qs][1]); pk.y = pk2(S[2 * kb][qs][2], S[2 * kb][qs][3]);
                    pk.z = pk2(S[2 * kb + 1][qs][0], S[2 * kb + 1][qs][1]); pk.w = pk2(S[2 * kb + 1][qs][2], S[2 * kb + 1][qs][3]);
                    pf[qs][kb] = as_bf8(pk);
                }
            }
#pragma unroll
            for (int dt = 0; dt < 4; ++dt)
#pragma unroll
                for (int kb = 0; kb < 2; ++kb) {
                    const int row = dt * 16 + fr;
                    const u32x2 v0 = *(const u32x2*)(Vb + swz(row, kb * 4 + (quad >> 1)) + (quad & 1) * 8);
                    const u32x2 v1 = *(const u32x2*)(Vb + swz(row, kb * 4 + 2 + (quad >> 1)) + (quad & 1) * 8);
                    const bf16x8 vf = as_bf8((u32x4){v0.x, v0.y, v1.x, v1.y});
                    O[pp][dt][0] = mfma16(vf, pf[0][kb], O[pp][dt][0]);
                    O[pp][dt][1] = mfma16(vf, pf[1][kb], O[pp][dt][1]);
                }
            {
                const bf16x8 ones = as_bf8((u32x4){0x3F803F80u, 0x3F803F80u, 0x3F803F80u, 0x3F803F80u});
#pragma unroll
                for (int kb = 0; kb < 2; ++kb) { Lacc[pp][0] = mfma16(ones, pf[0][kb], Lacc[pp][0]); Lacc[pp][1] = mfma16(ones, pf[1][kb], Lacc[pp][1]); }
            }
        }
        if (t + 1 < ntile) { *(u32x4*)(Ks + (buf ^ 1) * 8192 + swz(lrow, lch)) = rk; *(u32x4*)(Vs + (buf ^ 1) * 8192 + swz(lrow, lch)) = rv; }
        __syncthreads();
    }
#pragma unroll
    for (int pp = 0; pp < NP; ++pp)
#pragma unroll
        for (int qs = 0; qs < 2; ++qs) {
            const float lt = Lacc[pp][qs][0];
            const float inv = __builtin_amdgcn_rcpf(lt);
#pragma unroll
            for (int dt = 0; dt < 4; ++dt) O[pp][dt][qs] *= inv;
        }
}

template <int MODE>
__device__ void attn_item(PP p, int l, int grp, int b, int head, int qb, unsigned char* smem_blk) {
    const int tid = vtid(), lane = tid & 63, w = __builtin_amdgcn_readfirstlane(tid >> 6), fr = lane & 15, quad = lane >> 4;
    const int Lk = grp ? 1280 : 256;
    const int tokbase = grp ? 8192 + b * 1024 : b * 256;
    const u16* Z = (const u16*)(p->ws + WS_Z);
    u16* MIX = (u16*)(p->ws + WS_MIX);
    const int qcol = MODE ? 768 + head * 64 : head * 64;
    const int mcol = MODE ? 512 + head * 64 : head * 64;
    const u16* Kg = MODE ? (const u16*)(p->ws + WS_KB) + kv_off(grp, b, head, 4, 1280) : (const u16*)(p->ws + WS_KA) + kv_off(grp, b, head >> 2, 2, 1280);
    const u16* Vg = MODE ? (const u16*)(p->ws + WS_VBT) + kv_off(grp, b, head, 4, 1280) : (const u16*)(p->ws + WS_VAT) + kv_off(grp, b, head >> 2, 2, 1280);
    const float cscale = (MODE ? 0.17677669529663687f : 0.125f) * 1.4426950408889634f;

    bf16x8 qf[2][2];
#pragma unroll
    for (int qs = 0; qs < 2; ++qs)
#pragma unroll
        for (int ks = 0; ks < 2; ++ks)
            {
                const u32x4 raw = *(const u32x4*)(Z + (size_t)(tokbase + qb * 128 + w * 32 + qs * 16 + fr) * NIN + qcol + ks * 32 + quad * 8);
                float qv[8]; unpack8(raw, qv);
#pragma unroll
                for (int i = 0; i < 8; ++i) qv[i] *= cscale;
                qf[qs][ks] = as_bf8(pack8(qv));
            }

    f32x4 O[4][2];
    float lam = 0.f, lam_init = 0.f;
    if (MODE == 0) {
        f32x4 O1[1][4][2];
        attn_sweep<1>(Kg, Vg, Lk, qf, smem_blk, O1);
#pragma unroll
        for (int dt = 0; dt < 4; ++dt) { O[dt][0] = O1[0][dt][0]; O[dt][1] = O1[0][dt][1]; }
    } else {
        f32x4 O2[2][4][2];
        attn_sweep<2>(Kg, Vg, Lk, qf, smem_blk, O2);
        float s1 = 0.f, s2 = 0.f;
        for (int i = 0; i < 32; ++i) { s1 += p->in[I_LQ1][l * 32 + i] * p->in[I_LK1][l * 32 + i]; s2 += p->in[I_LQ2][l * 32 + i] * p->in[I_LK2][l * 32 + i]; }
        lam_init = 0.8f - 0.6f * expf(-0.3f * (float)l);
        lam = expf(s1) - expf(s2) + lam_init;
#pragma unroll
        for (int dt = 0; dt < 4; ++dt) { O[dt][0] = O2[0][dt][0] - lam * O2[1][dt][0]; O[dt][1] = O2[0][dt][1] - lam * O2[1][dt][1]; }
    }
#pragma unroll
    for (int qs = 0; qs < 2; ++qs) {
        const int tok = tokbase + qb * 128 + w * 32 + qs * 16 + fr;
        if (MODE == 1) {
            float ss = 0.f;
#pragma unroll
            for (int dt = 0; dt < 4; ++dt)
#pragma unroll
                for (int r = 0; r < 4; ++r) ss += O[dt][qs][r] * O[dt][qs][r];
            ss = rows_sum(ss);
            const float rstd = rsqrtf(ss * (1.f / 64.f) + EPS) * (1.f - lam_init);
#pragma unroll
            for (int dt = 0; dt < 4; ++dt) {
                const f32x4 g4 = *(const f32x4*)(p->in[I_BOG] + l * 64 + dt * 16 + quad * 4);
                O[dt][qs] *= g4 * rstd;
            }
        }
#pragma unroll
        for (int dt = 0; dt < 4; ++dt) {
            const int col = mcol + dt * 16 + quad * 4;
            const u32x2 ur = *(const u32x2*)(Z + (size_t)tok * NIN + 2080 + col);
            u32x2 ov;
            ov.x = pk2(O[dt][qs][0] * silu_f(bflo(ur.x)), O[dt][qs][1] * silu_f(bfhi(ur.x)));
            ov.y = pk2(O[dt][qs][2] * silu_f(bflo(ur.y)), O[dt][qs][3] * silu_f(bfhi(ur.y)));
            *(u32x2*)(MIX + (size_t)tok * DM + col) = ov;
        }
    }
    __syncthreads();
}


__device__ void gla_item(PP p, int l, int grp, int b, int h, int dir, unsigned char* smem) {
    const int tid = vtid(), lane = tid & 63, w = __builtin_amdgcn_readfirstlane(tid >> 6), fr = lane & 15, quad = lane >> 4;
    const int L = grp ? 1024 : 256, nch = L >> 6;
    const int tokbase = grp ? 8192 + b * 1024 : b * 256;
    const u16* Z = (const u16*)(p->ws + WS_Z);
    u16* MIX = (u16*)(p->ws + WS_MIX);
    float* OC = (float*)(p->ws + (dir ? WS_H : WS_OC));
    const u16* Vt = (const u16*)(p->ws + WS_CVT) + kv_off(grp, b, h, 4, 1024);
    u16* QtL = (u16*)smem;
    u16* KtL = (u16*)(smem + 5120);
    u16* KlT = (u16*)(smem + 10240);
    float* Dl = (float*)(smem + 14848);
    const float qscale = 0.17677669529663687f;

    {
        f32x4 Sacc[2][4];
        const float* s0 = (dir ? p->in[I_SCB] : p->in[I_SCF]) + (size_t)((b * 2 + l) * 4 + h) * 32 * 64;
#pragma unroll
        for (int dt = 0; dt < 2; ++dt)
#pragma unroll
            for (int et = 0; et < 4; ++et)
#pragma unroll
                for (int r = 0; r < 4; ++r) Sacc[dt][et][r] = grp ? s0[(dt * 16 + quad * 4 + r) * 64 + et * 16 + fr] : 0.f;
        float4 ng0, ng1; u32x4 nq, nk;
        {
            const int c0 = dir ? nch - 1 : 0;
            const float* gp = (const float*)(p->ws + WS_G) + (size_t)(tokbase + c0 * 64 + lane) * 256 + dir * 128 + h * 32 + 8 * w;
            ng0 = *(const float4*)gp; ng1 = *(const float4*)(gp + 4);
            const size_t zrow = (size_t)(tokbase + c0 * 64 + lane) * NIN;
            nq = *(const u32x4*)(Z + zrow + 1536 + h * 32 + 8 * w); nk = *(const u32x4*)(Z + zrow + 1664 + h * 32 + 8 * w);
        }
        for (int ci = 0; ci < nch; ++ci) {
            const int c = dir ? nch - 1 - ci : ci, t0 = c * 64;
            const float4 g0 = ng0, g1 = ng1; const u32x4 cq = nq, ck = nk;
            bf16x8 vfr[4][2];
#pragma unroll
            for (int et = 0; et < 4; ++et)
#pragma unroll
                for (int jb = 0; jb < 2; ++jb) {
                    const u16* vp = Vt + (size_t)(et * 16 + fr) * L + t0 + jb * 32 + quad * 4;
                    const u32x2 a = *(const u32x2*)vp, a2 = *(const u32x2*)(vp + 16);
                    vfr[et][jb] = as_bf8((u32x4){a.x, a.y, a2.x, a2.y});
                }
            if (ci + 1 < nch) {
                const int cn = dir ? nch - 2 - ci : ci + 1;
                const float* gp = (const float*)(p->ws + WS_G) + (size_t)(tokbase + cn * 64 + lane) * 256 + dir * 128 + h * 32 + 8 * w;
                ng0 = *(const float4*)gp; ng1 = *(const float4*)(gp + 4);
                const size_t zrow = (size_t)(tokbase + cn * 64 + lane) * NIN;
                nq = *(const u32x4*)(Z + zrow + 1536 + h * 32 + 8 * w); nk = *(const u32x4*)(Z + zrow + 1664 + h * 32 + 8 * w);
            }
            {
                float q[8], k[8], g[8], pre[8];
                g[0] = g0.x; g[1] = g0.y; g[2] = g0.z; g[3] = g0.w; g[4] = g1.x; g[5] = g1.y; g[6] = g1.z; g[7] = g1.w;
#pragma unroll
                for (int dd = 0; dd < 8; ++dd) pre[dd] = g[dd];
                unpack8(cq, q);
                unpack8(ck, k);
#pragma unroll
                for (int off = 1; off < 64; off <<= 1)
#pragma unroll
                    for (int dd = 0; dd < 8; ++dd) { const float tv = __shfl_up(pre[dd], off); if (lane >= off) pre[dd] += tv; }
                float qt[8], kt8[8];
#pragma unroll
                for (int dd = 0; dd < 8; ++dd) {
                    const float tot = __shfl(pre[dd], 63);
                    const float cum = dir ? (tot - pre[dd] + g[dd]) : pre[dd];
                    qt[dd] = q[dd] * qscale * __expf(cum);
                    kt8[dd] = k[dd] * __expf(-cum);
                    const float kl = k[dd] * __expf(tot - cum);
                    KlT[(8 * w + dd) * 72 + lane] = (u16)(pk2(kl, 0.f) & 0xffff);
                    if (lane == 0) Dl[8 * w + dd] = __expf(tot);
                }
                *(u32x4*)(QtL + lane * 40 + 8 * w) = pack8(qt);
                *(u32x4*)(KtL + lane * 40 + 8 * w) = pack8(kt8);
            }
            __syncthreads();
            const bf16x8 qstd = *(const bf16x8*)(QtL + (16 * w + fr) * 40 + quad * 8);
            f32x4 PT[4];
#pragma unroll
            for (int jt = 0; jt < 4; ++jt) {
                PT[jt] = (f32x4){0.f, 0.f, 0.f, 0.f};
                const bool need = dir ? (jt >= w) : (jt <= w);
                if (need) {
                    const bf16x8 kfr = *(const bf16x8*)(KtL + (jt * 16 + fr) * 40 + quad * 8);
                    PT[jt] = mfma16(kfr, qstd, PT[jt]);
                    if (jt == w) {
#pragma unroll
                        for (int r = 0; r < 4; ++r) { const int jj = quad * 4 + r; const bool keep = dir ? (jj >= fr) : (jj <= fr); if (!keep) PT[jt][r] = 0.f; }
                    }
                }
            }
            bf16x8 pa[2];
#pragma unroll
            for (int jb = 0; jb < 2; ++jb) {
                u32x4 pk; pk.x = pk2(PT[2 * jb][0], PT[2 * jb][1]); pk.y = pk2(PT[2 * jb][2], PT[2 * jb][3]);
                pk.z = pk2(PT[2 * jb + 1][0], PT[2 * jb + 1][1]); pk.w = pk2(PT[2 * jb + 1][2], PT[2 * jb + 1][3]);
                pa[jb] = as_bf8(pk);
            }
            bf16x8 qrel;
            {
                const u32x2 a = *(const u32x2*)(QtL + (16 * w + fr) * 40 + quad * 4), a2 = *(const u32x2*)(QtL + (16 * w + fr) * 40 + 16 + quad * 4);
                qrel = as_bf8((u32x4){a.x, a.y, a2.x, a2.y});
            }
            f32x4 Oacc[4];
#pragma unroll
            for (int et = 0; et < 4; ++et) {
                Oacc[et] = (f32x4){0.f, 0.f, 0.f, 0.f};
                Oacc[et] = mfma16(pa[0], vfr[et][0], Oacc[et]);
                Oacc[et] = mfma16(pa[1], vfr[et][1], Oacc[et]);
                u32x4 sb; sb.x = pk2(Sacc[0][et][0], Sacc[0][et][1]); sb.y = pk2(Sacc[0][et][2], Sacc[0][et][3]);
                sb.z = pk2(Sacc[1][et][0], Sacc[1][et][1]); sb.w = pk2(Sacc[1][et][2], Sacc[1][et][3]);
                Oacc[et] = mfma16(qrel, as_bf8(sb), Oacc[et]);
            }
#pragma unroll
            for (int dt = 0; dt < 2; ++dt) {
                bf16x8 klf[2];
#pragma unroll
                for (int jb = 0; jb < 2; ++jb) {
                    const u32x2 a = *(const u32x2*)(KlT + (dt * 16 + fr) * 72 + jb * 32 + quad * 4), a2 = *(const u32x2*)(KlT + (dt * 16 + fr) * 72 + jb * 32 + 16 + quad * 4);
                    klf[jb] = as_bf8((u32x4){a.x, a.y, a2.x, a2.y});
                }
                float dec[4];
#pragma unroll
                for (int r = 0; r < 4; ++r) dec[r] = Dl[dt * 16 + quad * 4 + r];
#pragma unroll
                for (int et = 0; et < 4; ++et) {
                    f32x4 hacc;
#pragma unroll
                    for (int r = 0; r < 4; ++r) hacc[r] = dec[r] * Sacc[dt][et][r];
                    hacc = mfma16(klf[0], vfr[et][0], hacc);
                    hacc = mfma16(klf[1], vfr[et][1], hacc);
                    Sacc[dt][et] = hacc;
                }
            }
#pragma unroll
            for (int r = 0; r < 4; ++r) {
                const int tok = tokbase + t0 + 16 * w + quad * 4 + r;
                float* ocp = OC + (size_t)tok * 256 + h * 64 + fr;
#pragma unroll
                for (int et = 0; et < 4; ++et) ocp[et * 16] = Oacc[et][r];
            }
            __syncthreads();
        }
        if (!grp && w == 0) {
            float* so = p->out + (dir ? OUT_SB : OUT_SF) + (size_t)((b * 2 + l) * 4 + h) * 32 * 64;
#pragma unroll
            for (int dt = 0; dt < 2; ++dt)
#pragma unroll
                for (int et = 0; et < 4; ++et)
#pragma unroll
                    for (int r = 0; r < 4; ++r) so[(dt * 16 + quad * 4 + r) * 64 + et * 16 + fr] = Sacc[dt][et][r];
        }
        __syncthreads();
    }
}

__device__ __forceinline__ void gla_combine(PP p, int l, int grp, int b, int h) {
    const int tid = opaque_tid(), l16 = tid & 15, rowl = tid >> 4;
    const int L = grp ? 1024 : 256, tokbase = grp ? 8192 + b * 1024 : b * 256;
    const float* OCf = (const float*)(p->ws + WS_OC);
    const float* OCb = (const float*)(p->ws + WS_H);
    const u16* Z = (const u16*)(p->ws + WS_Z);
    u16* MIX = (u16*)(p->ws + WS_MIX);
    const float4 g = *(const float4*)(p->in[I_COG] + l * 64 + l16 * 4);
#pragma unroll 4
    for (int r0 = 0; r0 < L; r0 += 32) {
        const size_t tok = (size_t)(tokbase + r0 + rowl);
        const float4 a = *(const float4*)(OCf + tok * 256 + h * 64 + l16 * 4), c = *(const float4*)(OCb + tok * 256 + h * 64 + l16 * 4);
        const float o0 = a.x + c.x, o1 = a.y + c.y, o2 = a.z + c.z, o3 = a.w + c.w;
        float ss = o0 * o0 + o1 * o1 + o2 * o2 + o3 * o3;
        ss = sum16(ss);
        const float rstd = rsqrtf(ss * (1.f / 64.f) + EPS);
        const u32x2 ur = *(const u32x2*)(Z + tok * NIN + 2080 + 768 + h * 64 + l16 * 4);
        u32x2 ov;
        ov.x = pk2(o0 * rstd * g.x * silu_f(bflo(ur.x)), o1 * rstd * g.y * silu_f(bfhi(ur.x)));
        ov.y = pk2(o2 * rstd * g.z * silu_f(bflo(ur.y)), o3 * rstd * g.w * silu_f(bfhi(ur.y)));
        *(u32x2*)(MIX + tok * DM + 768 + h * 64 + l16 * 4) = ov;
    }
}

__device__ void mix_phase(PP p, int l, int ctr_idx, unsigned char* smem_blk) {
    unsigned* ctr = (unsigned*)(p->ws + WS_CTR) + ctr_idx;
    volatile int* s_item = (volatile int*)(smem_blk + 65024);
    const int hb = half_id();
    unsigned char* smem = smem_blk + hb * 65536;
    for (;;) {
        if (opaque_tid() == 0) *s_item = (int)atomicAdd(ctr, 1u);
        __syncthreads();
        const int pi = __builtin_amdgcn_readfirstlane(*s_item);
        __syncthreads();
#if PROBE_DUP == 1
        if (pi >= 928 + 256) break;
        const int pj = pi < 928 ? pi : pi - 928 + 160;
#elif PROBE_DUP == 2
        if (pi >= 928 + 384) break;
        const int pj = pi < 928 ? pi : pi - 928 + 544;
#elif PROBE_DUP == 3
        if (pi >= 928 + 128) break;
        const int pj = pi < 928 ? pi : pi - 928 + 32;
#else
        if (pi >= 928) break;
        const int pj = pi;
#endif
        const int idx = 2 * pj + hb;
        asm volatile("" : "+s"(p));
        int kind, grp, b, h, qb = 0;
        if (idx < 64) { kind = 0; grp = 1; b = idx >> 3; h = (idx >> 1) & 3; qb = idx & 1; }
        else if (idx < 320) { const int j = idx - 64; kind = 1; grp = 1; b = j >> 5; h = (j >> 3) & 3; qb = j & 7; }
        else if (idx < 832) { const int j = idx - 320; kind = 2; grp = 1; b = j >> 6; h = (j >> 3) & 7; qb = j & 7; }
        else if (idx < 1088) { const int j = idx - 832; kind = 0; grp = 0; b = j >> 3; h = (j >> 1) & 3; qb = j & 1; }
        else if (idx < 1344) { const int j = idx - 1088; kind = 1; grp = 0; b = j >> 3; h = (j >> 1) & 3; qb = j & 1; }
        else { const int j = idx - 1344; kind = 2; grp = 0; b = j >> 4; h = (j >> 1) & 7; qb = j & 1; }
        if (kind == 0) { gla_item(p, l, grp, b, h, qb, smem); gla_combine(p, l, grp, b, h); }
        else if (kind == 1) attn_item<1>(p, l, grp, b, h, qb, smem_blk);
        else attn_item<0>(p, l, grp, b, h, qb, smem_blk);
    }
}

#define XB_TMO      128
#define XB_XCNT(j)  (256  + 64 * (j))
#define XB_XSUB(j)  (1280 + 64 * (j))
#define XB_XGEN(j)  (2304 + 64 * (j))
#define XB_TOP      3328
#define XB_TOPGEN   3392
#define XCD_BAR_WORDS 3456
#define XB_SPIN_CAP (1u << 18)
#define LAS __attribute__((address_space(3)))

__device__ __forceinline__ unsigned xb_ld(unsigned* p)              { return __hip_atomic_load(p, __ATOMIC_RELAXED, __HIP_MEMORY_SCOPE_AGENT); }
__device__ __forceinline__ unsigned xb_add(unsigned* p, unsigned v) { return __hip_atomic_fetch_add(p, v, __ATOMIC_RELAXED, __HIP_MEMORY_SCOPE_AGENT); }
__device__ __forceinline__ unsigned xb_xcc_id() { return (unsigned)__builtin_amdgcn_s_getreg((3 << 11) | 20) & 0xFu; }
#define XB_SPIN(cond, bar) do { unsigned _sp = 0; while (cond) { __builtin_amdgcn_s_sleep(1); \
    if ((++_sp & 255u) == 0u) { if (xb_ld(&(bar)[XB_TMO])) break; if (_sp > XB_SPIN_CAP) { atomicAdd(&(bar)[XB_TMO], 1u); break; } } } } while (0)

struct XcdBarrier {
    unsigned* bar; unsigned x;
    volatile LAS unsigned* st;
};

__device__ __forceinline__ XcdBarrier xcd_barrier_post(unsigned* bar, volatile LAS unsigned* st) {
    XcdBarrier b; b.bar = bar; b.x = xb_xcc_id(); b.st = st;
    if (threadIdx.x == 0) (void)xb_add(&bar[XB_XCNT(b.x)], 1u);
    return b;
}
__device__ __forceinline__ void xcd_barrier_complete(unsigned* bar, unsigned x, unsigned& nloc, unsigned& nx) {
    const unsigned G = gridDim.x * gridDim.y * gridDim.z;
    unsigned sum, cnt, mine, sp = 0u;
    for (;;) {
        sum = 0u; cnt = 0u; mine = 0u;
#pragma unroll
        for (unsigned j = 0; j < 16; ++j) { const unsigned c = xb_ld(&bar[XB_XCNT(j)]); sum += c; cnt += (c > 0u) ? 1u : 0u; mine = (j == x) ? c : mine; }
        if (sum == G) break;
        __builtin_amdgcn_s_sleep(1);
        if ((++sp & 255u) == 0u) { if (xb_ld(&bar[XB_TMO])) break; if (sp > XB_SPIN_CAP) { atomicAdd(&bar[XB_TMO], 1u); break; } }
    }
    nloc = mine > 0u ? mine : 1u; nx = cnt > 0u ? cnt : 1u;
}

__device__ __forceinline__ void xcd_barrier(const XcdBarrier& b) {
    asm volatile("s_waitcnt vmcnt(0)" ::: "memory");
    __syncthreads();
    if (threadIdx.x == 0) {
        unsigned* bar = b.bar;
        __builtin_amdgcn_s_waitcnt(0);
        unsigned nloc = b.st[0], nx = b.st[1];
        if (nloc == 0u) { xcd_barrier_complete(bar, b.x, nloc, nx); b.st[0] = nloc; b.st[1] = nx; }
        const unsigned old = xb_add(&bar[XB_XSUB(b.x)], 1u);
        const unsigned gen = old / nloc;
        if (old + 1u == (gen + 1u) * nloc) {
            __builtin_amdgcn_fence(__ATOMIC_RELEASE, "agent");
            asm volatile("s_waitcnt vmcnt(0)" ::: "memory");
            const unsigned og = xb_add(&bar[XB_TOP], 1u);
            const unsigned tg = og / nx;
            if (og + 1u == (tg + 1u) * nx) xb_add(&bar[XB_TOPGEN], 1u);
            else XB_SPIN(xb_ld(&bar[XB_TOPGEN]) == tg, bar);
            __builtin_amdgcn_fence(__ATOMIC_ACQUIRE, "agent");
            xb_add(&bar[XB_XGEN(b.x)], 1u);
            asm volatile("s_waitcnt vmcnt(0)" ::: "memory");
        } else {
            XB_SPIN(xb_ld(&bar[XB_XGEN(b.x)]) == gen, bar);
            __builtin_amdgcn_fence(__ATOMIC_ACQUIRE, "agent");
            asm volatile("s_waitcnt vmcnt(0)" ::: "memory");
        }
    }
    __syncthreads();
}


__global__ void __launch_bounds__(NTHREADS, 1) mega_fwd(Params p_unused, int ph_lo, int ph_hi) {
    extern __shared__ __attribute__((aligned(16))) unsigned char smem[];
    __shared__ uint4 xb_words;
    if (threadIdx.x == 0) xb_words = make_uint4(0u, 0u, 0u, 0u);
    __syncthreads();
    const XcdBarrier xb = xcd_barrier_post((unsigned*)(((PP)__builtin_amdgcn_kernarg_segment_ptr())->ws + WS_BAR), (volatile LAS unsigned*)&xb_words);
    unsigned char* const smem_h = smem + half_id() * 65536;
    for (int ph = ph_lo; ph < ph_hi; ++ph) {
        PP p = (PP)__builtin_amdgcn_kernarg_segment_ptr();
        asm volatile("" : "+s"(p));
        for (int rep = 0; rep < (((PROBE_MASK >> ph) & 1) ? 2 : 1); ++rep) {
            if (rep) xcd_barrier(xb);
            if (ph == 0) prep_phase(p, smem_h);
            else if (ph == 1) prenorm_phase(p);
            else {
                const int l = (ph - 2) / 5, s = (ph - 2) % 5;
                if (s == 0 || s == 3) {
                    const bool inp = (s == 0);
                    gemm_phase((const u16*)(p->ws + (inp ? WS_H : WS_MIX)), inp ? (const u16*)(p->ws + WS_WIN) + (size_t)l * NINP * DM : (const u16*)(p->ws + WS_WOUT) + (size_t)l * DM * DM,
                               inp ? 12 : 4, (u16*)(p->ws + WS_Z), inp ? NIN : DM, inp ? 2 : 0, smem);
                }
                else if (s == 1) post_phase(p, l, smem_h);
                else if (s == 2) mix_phase(p, l, 2 * rep + l, smem);
                else final_phase(p, l);
            }
        }
        if (ph + 1 < ph_hi) { if (ph_hi == 0x7fffffff) cg::this_grid().sync(); else xcd_barrier(xb); }
    }
}

extern "C" void kernel_launch(void* const* d_in, const int* in_sizes, int n_in, void* d_out, int out_size, void* d_ws, size_t ws_size, hipStream_t stream) {
    static int grid = 0;
    if (grid == 0) {
        if (n_in != 28 || ws_size < WS_END) { fprintf(stderr, "kernel_launch: unexpected n_in %d / ws_size %zu (need %zu)\n", n_in, ws_size, (size_t)WS_END); grid = -1; return; }
        int dev = 0, cus = 0, per_cu = 0;
        (void)hipGetDevice(&dev);
        (void)hipDeviceGetAttribute(&cus, hipDeviceAttributeMultiprocessorCount, dev);
        if (hipFuncSetAttribute((const void*)mega_fwd, hipFuncAttributeMaxDynamicSharedMemorySize, 131072) != hipSuccess) fprintf(stderr, "kernel_launch: hipFuncSetAttribute failed\n");
        if (hipOccupancyMaxActiveBlocksPerMultiprocessor(&per_cu, (const void*)mega_fwd, NTHREADS, 131072) != hipSuccess || per_cu < 1) { fprintf(stderr, "kernel_launch: occupancy query failed (%d)\n", per_cu); per_cu = 1; }
        if (per_cu > 1) per_cu = 1;
        grid = cus * per_cu;
        fprintf(stderr, "kernel_launch: cus %d per_cu %d grid %d\n", cus, per_cu, grid);
    }
    if (grid < 0) return;
    (void)hipMemsetAsync((unsigned char*)d_ws + WS_BAR, 0, 3456 * 4, stream);
    Params p{};
    for (int i = 0; i < 28; ++i) p.in[i] = (const float*)d_in[i];
    p.out = (float*)d_out; p.ws = (unsigned char*)d_ws;
#if N_LAUNCH_SPLIT
    for (int ph = 0; ph < 12; ++ph) hipLaunchKernelGGL(mega_fwd, dim3(grid), dim3(NTHREADS), 131072, stream, p, ph, ph + 1);
#else
    int lo = 0, hi = 12;
    void* args[] = {&p, &lo, &hi};
    hipError_t e = hipLaunchCooperativeKernel((const void*)mega_fwd, dim3(grid), dim3(NTHREADS), args, 131072, stream);
    if (e != hipSuccess) fprintf(stderr, "cooperative launch failed: %s (grid %d)\n", hipGetErrorString(e), grid);
#endif
}
```

```cpp
#include <hip/hip_runtime.h>
#include <hip/hip_cooperative_groups.h>
#include <cstdio>
#include <cstdint>
namespace cg = cooperative_groups;

typedef unsigned short u16;
typedef short bf16x8 __attribute__((ext_vector_type(8)));
typedef float f32x4 __attribute__((ext_vector_type(4)));
typedef unsigned u32x4 __attribute__((ext_vector_type(4)));
typedef unsigned u32x2 __attribute__((ext_vector_type(2)));

#ifndef PROBE_MASK
#define PROBE_MASK 0
#endif
#ifndef PROBE_DUP
#define PROBE_DUP 0
#endif
#define N_LAUNCH_SPLIT 0

constexpr int NTOK = 16384, DM = 1024, NIN = 3104, NINP = 3200;
constexpr int NTHREADS = 512;
constexpr int VT = 256;
constexpr float EPS = 1e-6f;

constexpr size_t WS_WIN  = 0;
constexpr size_t WS_WOUT = WS_WIN  + (size_t)2 * NINP * DM * 2;
constexpr size_t WS_MOD  = WS_WOUT + (size_t)2 * DM * DM * 2;
constexpr size_t WS_ROPE = WS_MOD  + (size_t)2 * 9 * 3072 * 4;
constexpr size_t WS_CTR  = WS_ROPE + 64 * 16 * 8;
constexpr size_t WS_H    = WS_CTR  + 256;
constexpr size_t WS_Z    = WS_H    + (size_t)NTOK * DM * 2;
constexpr size_t WS_MIX  = WS_Z    + (size_t)NTOK * NIN * 2;
constexpr size_t WS_KA   = WS_MIX  + (size_t)NTOK * DM * 2;
constexpr size_t KA_ELEMS = (size_t)(32 * 2 * 256 + 8 * 2 * 1280) * 64;
constexpr size_t KB_ELEMS = (size_t)(32 * 4 * 256 + 8 * 4 * 1280) * 64;
constexpr size_t CV_ELEMS = (size_t)(32 * 4 * 256 + 8 * 4 * 1024) * 64;
constexpr size_t WS_VAT  = WS_KA  + KA_ELEMS * 2;
constexpr size_t WS_KB   = WS_VAT + KA_ELEMS * 2;
constexpr size_t WS_VBT  = WS_KB  + KB_ELEMS * 2;
constexpr size_t WS_CVT  = WS_VBT + KB_ELEMS * 2;
constexpr size_t WS_OC   = WS_CVT + CV_ELEMS * 2;
constexpr size_t WS_G    = WS_OC  + (size_t)NTOK * 256 * 4;
constexpr size_t WS_BAR  = WS_G   + (size_t)NTOK * 256 * 4;
constexpr size_t WS_END  = WS_BAR + 3456 * 4;

constexpr size_t OUT_Y   = 0;
constexpr size_t OUT_AK  = 16777216;
constexpr size_t OUT_AV  = OUT_AK + 2097152;
constexpr size_t OUT_BK  = OUT_AV + 2097152;
constexpr size_t OUT_BV  = OUT_BK + 4194304;
constexpr size_t OUT_SF  = OUT_BV + 4194304;
constexpr size_t OUT_SB  = OUT_SF + 524288;

struct Params {
    const float* in[28];
    float* out;
    unsigned char* ws;
};
typedef const __attribute__((address_space(4))) Params* PP;
enum { I_XP = 0, I_XS, I_C, I_CAK, I_CAV, I_CBK, I_CBV, I_SCF, I_SCB, I_CCTX, I_WMOD, I_BMOD, I_GPRE, I_GPOST, I_WIN, I_WOUT,
       I_AQG, I_AKG, I_LQ1, I_LK1, I_LQ2, I_LK2, I_BOG, I_CWF, I_CBF, I_CWB, I_CBB, I_COG };

__device__ __forceinline__ int opaque_tid() { int t = threadIdx.x; asm volatile("" : "+v"(t)); return t; }
__device__ __forceinline__ int vtid() { return opaque_tid() & 255; }
__device__ __forceinline__ int half_id() { return __builtin_amdgcn_readfirstlane(threadIdx.x >> 8); }
typedef __bf16 bf16x2_t __attribute__((ext_vector_type(2)));
typedef float f32x2_t __attribute__((ext_vector_type(2)));
__device__ __forceinline__ unsigned pk2(float lo, float hi) { const f32x2_t v = {lo, hi}; return __builtin_bit_cast(unsigned, __builtin_convertvector(v, bf16x2_t)); }
__device__ __forceinline__ float bflo(unsigned w) { return __uint_as_float(w << 16); }
__device__ __forceinline__ float bfhi(unsigned w) { return __uint_as_float(w & 0xffff0000u); }
__device__ __forceinline__ float fast_exp2(float x) { return __builtin_amdgcn_exp2f(x); }
__device__ __forceinline__ float silu_f(float v) { return v * __builtin_amdgcn_rcpf(1.f + __expf(-v)); }
template <int CTRL> __device__ __forceinline__ float dppf(float v) { return __int_as_float(__builtin_amdgcn_mov_dpp(__float_as_int(v), CTRL, 0xf, 0xf, true)); }
__device__ __forceinline__ float xor1f(float v) { return dppf<0xB1>(v); }
__device__ __forceinline__ float xor2f(float v) { return dppf<0x4E>(v); }
__device__ __forceinline__ float sum8(float v) { v += xor1f(v); v += xor2f(v); v += dppf<0x141>(v); return v; }
__device__ __forceinline__ float sum16(float v) { v = sum8(v); v += dppf<0x140>(v); return v; }
__device__ __forceinline__ float rows_sum(float v) {
    unsigned u = __float_as_uint(v);
    auto r = __builtin_amdgcn_permlane16_swap(u, u, false, false);
    v = __uint_as_float(r[0]) + __uint_as_float(r[1]);
    u = __float_as_uint(v);
    auto r2 = __builtin_amdgcn_permlane32_swap(u, u, false, false);
    return __uint_as_float(r2[0]) + __uint_as_float(r2[1]);
}
__device__ __forceinline__ float wave_sum(float v) { return rows_sum(sum16(v)); }
__device__ __forceinline__ f32x4 mfma16(bf16x8 a, bf16x8 b, f32x4 c) { return __builtin_amdgcn_mfma_f32_16x16x32_bf16(a, b, c, 0, 0, 0); }
__device__ __forceinline__ bf16x8 as_bf8(u32x4 v) { return __builtin_bit_cast(bf16x8, v); }
__device__ __forceinline__ int swz(int row, int chunk) { return row * 128 + ((chunk ^ ((row >> 1) & 7)) << 4); }
__device__ __forceinline__ size_t kv_off(int grp, int b, int h, int H, int LS) {
    return grp ? ((size_t)32 * H * 256 + (size_t)(b * H + h) * LS) * 64 : (size_t)(b * H + h) * 256 * 64;
}

__device__ void prep_phase(PP p, unsigned char* smem) {
    const int tid = vtid(), lane = tid & 63, w = __builtin_amdgcn_readfirstlane(tid >> 6), hb = half_id();
    constexpr int NMOD = 192, NT_IN = 16 * 50, NT_OUT = 16 * 16;
    constexpr int NITEMS = NMOD + 2 * (NT_IN + NT_OUT) + 1;
    float* MODW = (float*)(p->ws + WS_MOD);
    for (int it0 = blockIdx.x * 2; it0 < NITEMS + 1; it0 += gridDim.x * 2) {
        const int it = it0 + hb;
        asm volatile("" : "+s"(p));
        if (it < NMOD) {
            const int l = it / 96, cgp = it % 96;
            float* red = (float*)smem;
            const int cq = tid & 7, kg = tid >> 3;
            const float* wp = p->in[I_WMOD] + (size_t)l * 1024 * 3072 + cgp * 32 + cq * 4;
            const float* cc = p->in[I_C]; const float* cx = p->in[I_CCTX];
            float acc[9][4];
#pragma unroll
            for (int r = 0; r < 9; ++r) { acc[r][0] = 0.f; acc[r][1] = 0.f; acc[r][2] = 0.f; acc[r][3] = 0.f; }
#pragma unroll 4
            for (int kk = 0; kk < 32; ++kk) {
                const int k = kg * 32 + kk;
                const float4 w4 = *(const float4*)(wp + (size_t)k * 3072);
                float cv[9];
                cv[0] = cx[k];
#pragma unroll
                for (int r = 1; r < 9; ++r) cv[r] = cc[(r - 1) * 1024 + k];
#pragma unroll
                for (int r = 0; r < 9; ++r) { const float s = cv[r] * __builtin_amdgcn_rcpf(1.f + __expf(-cv[r])); acc[r][0] += s * w4.x; acc[r][1] += s * w4.y; acc[r][2] += s * w4.z; acc[r][3] += s * w4.w; }
            }
#pragma unroll
            for (int r = 0; r < 9; ++r)
#pragma unroll
                for (int j = 0; j < 4; ++j) { float v = acc[r][j]; v += dppf<0x128>(v); v = rows_sum(v); acc[r][j] = v; }
            if ((lane >> 3) == 0) {
#pragma unroll
                for (int r = 0; r < 9; ++r)
#pragma unroll
                    for (int j = 0; j < 4; ++j) red[(w * 9 + r) * 32 + cq * 4 + j] = acc[r][j];
            }
            __syncthreads();
            for (int i = tid; i < 288; i += VT) {
                const int r = i >> 5, c = i & 31;
                const float v = red[(0 * 9 + r) * 32 + c] + red[(1 * 9 + r) * 32 + c] + red[(2 * 9 + r) * 32 + c] + red[(3 * 9 + r) * 32 + c] + p->in[I_BMOD][l * 3072 + cgp * 32 + c];
                MODW[(size_t)(l * 9 + r) * 3072 + cgp * 32 + c] = v;
            }
        } else if (it < NITEMS - 1) {
            int r = it - NMOD;
            const float* src; u16* dst; int N, NT;
            if (r < 2 * NT_IN) { const int l = r / NT_IN; r %= NT_IN; src = p->in[I_WIN] + (size_t)l * 1024 * NIN; dst = (u16*)(p->ws + WS_WIN) + (size_t)l * NINP * DM; N = NIN; NT = 50; }
            else { r -= 2 * NT_IN; const int l = r / NT_OUT; r %= NT_OUT; src = p->in[I_WOUT] + (size_t)l * 1024 * 1024; dst = (u16*)(p->ws + WS_WOUT) + (size_t)l * DM * DM; N = 1024; NT = 16; }
            const int kt = r / NT, nt = r % NT, k0 = kt * 64, n0 = nt * 64;
            float* T = (float*)smem;
#pragma unroll
            for (int i = 0; i < 4; ++i) {
                const int rr = (tid >> 4) + 16 * i, c = (tid & 15) * 4;
                float4 v = make_float4(0.f, 0.f, 0.f, 0.f);
                if (n0 + c < N) v = *(const float4*)(src + (size_t)(k0 + rr) * N + n0 + c);
                T[rr * 65 + c] = v.x; T[rr * 65 + c + 1] = v.y; T[rr * 65 + c + 2] = v.z; T[rr * 65 + c + 3] = v.w;
            }
            __syncthreads();
            const int n = tid >> 2, kq = tid & 3;
            u32x4 o0, o1;
            o0.x = pk2(T[(kq * 16 + 0) * 65 + n], T[(kq * 16 + 1) * 65 + n]);   o0.y = pk2(T[(kq * 16 + 2) * 65 + n], T[(kq * 16 + 3) * 65 + n]);
            o0.z = pk2(T[(kq * 16 + 4) * 65 + n], T[(kq * 16 + 5) * 65 + n]);   o0.w = pk2(T[(kq * 16 + 6) * 65 + n], T[(kq * 16 + 7) * 65 + n]);
            o1.x = pk2(T[(kq * 16 + 8) * 65 + n], T[(kq * 16 + 9) * 65 + n]);   o1.y = pk2(T[(kq * 16 + 10) * 65 + n], T[(kq * 16 + 11) * 65 + n]);
            o1.z = pk2(T[(kq * 16 + 12) * 65 + n], T[(kq * 16 + 13) * 65 + n]); o1.w = pk2(T[(kq * 16 + 14) * 65 + n], T[(kq * 16 + 15) * 65 + n]);
            u16* d = dst + (size_t)(n0 + n) * DM + k0 + kq * 16;
            *(u32x4*)d = o0; *(u32x4*)(d + 8) = o1;
        } else {
            float2* tab = (float2*)(p->ws + WS_ROPE);
            for (int i = tid; i < (it == NITEMS - 1 ? 1024 : 0); i += VT) {
                const int pos = i >> 4, fi = i & 15;
                const float freq = powf(10000.f, -(float)fi / 16.f);
                const float ang = (float)pos * freq;
                float s, c; sincosf(ang, &s, &c);
                tab[i] = make_float2(c, s);
            }
            if (it == NITEMS - 1 && tid < 8) ((unsigned*)(p->ws + WS_CTR))[tid] = 0u;
        }
        __syncthreads();
    }
}

__device__ __forceinline__ void prenorm_phase(PP p) {
    const int tid = opaque_tid(), lane = tid & 63, w = __builtin_amdgcn_readfirstlane(tid >> 6);
    const float* MODW = (const float*)(p->ws + WS_MOD);
    u16* H = (u16*)(p->ws + WS_H);
#pragma unroll 2
    for (int row = blockIdx.x * 8 + w; row < NTOK; row += gridDim.x * 8) {
        const float* xr = row < 8192 ? p->in[I_XP] + (size_t)row * DM : p->in[I_XS] + (size_t)(row - 8192) * DM;
        const int mrow = row < 8192 ? 0 : 1 + ((row - 8192) >> 10);
        const float* md = MODW + (size_t)mrow * 3072;
        float4 v[4]; float ss = 0.f;
#pragma unroll
        for (int j = 0; j < 4; ++j) { v[j] = *(const float4*)(xr + lane * 4 + 256 * j); ss += v[j].x * v[j].x + v[j].y * v[j].y + v[j].z * v[j].z + v[j].w * v[j].w; }
        const float rstd = rsqrtf(wave_sum(ss) * (1.f / DM) + EPS);
#pragma unroll
        for (int j = 0; j < 4; ++j) {
            const int c = lane * 4 + 256 * j;
            const float4 g = *(const float4*)(p->in[I_GPRE] + c), sh = *(const float4*)(md + c), scl = *(const float4*)(md + 1024 + c);
            u32x2 o;
            o.x = pk2(v[j].x * rstd * g.x * (1.f + scl.x) + sh.x, v[j].y * rstd * g.y * (1.f + scl.y) + sh.y);
            o.y = pk2(v[j].z * rstd * g.z * (1.f + scl.z) + sh.z, v[j].w * rstd * g.w * (1.f + scl.w) + sh.w);
            *(u32x2*)(H + (size_t)row * DM + c) = o;
        }
    }
}

__device__ __forceinline__ void final_phase(PP p, int l) {
    const int tid = opaque_tid(), lane = tid & 63, w = __builtin_amdgcn_readfirstlane(tid >> 6);
    const float* MODW = (const float*)(p->ws + WS_MOD);
    const u16* Y = (const u16*)(p->ws + WS_Z);
    u16* H = (u16*)(p->ws + WS_H);
#pragma unroll 2
    for (int row = blockIdx.x * 8 + w; row < NTOK; row += gridDim.x * 8) {
        const float* xr = (l == 0) ? (row < 8192 ? p->in[I_XP] + (size_t)row * DM : p->in[I_XS] + (size_t)(row - 8192) * DM) : p->out + OUT_Y + (size_t)row * DM;
        const int mrow = row < 8192 ? 0 : 1 + ((row - 8192) >> 10);
        const float* md = MODW + (size_t)(l * 9 + mrow) * 3072;
        float4 y[4], x[4]; float ss = 0.f;
#pragma unroll
        for (int j = 0; j < 4; ++j) {
            { const u32x2 yr = *(const u32x2*)(Y + (size_t)row * DM + lane * 4 + 256 * j); y[j] = make_float4(bflo(yr.x), bfhi(yr.x), bflo(yr.y), bfhi(yr.y)); }
            x[j] = *(const float4*)(xr + lane * 4 + 256 * j);
            ss += y[j].x * y[j].x + y[j].y * y[j].y + y[j].z * y[j].z + y[j].w * y[j].w;
        }
        const float rstd = rsqrtf(wave_sum(ss) * (1.f / DM) + EPS);
        float ss2 = 0.f;
#pragma unroll
        for (int j = 0; j < 4; ++j) {
            const int c = lane * 4 + 256 * j;
            const float4 g = *(const float4*)(p->in[I_GPOST] + l * DM + c), gt = *(const float4*)(md + 2048 + c);
            x[j].x += gt.x * (y[j].x * rstd * g.x); x[j].y += gt.y * (y[j].y * rstd * g.y); x[j].z += gt.z * (y[j].z * rstd * g.z); x[j].w += gt.w * (y[j].w * rstd * g.w);
            *(float4*)(p->out + OUT_Y + (size_t)row * DM + c) = x[j];
            ss2 += x[j].x * x[j].x + x[j].y * x[j].y + x[j].z * x[j].z + x[j].w * x[j].w;
        }
        if (l == 0) {
            const float rstd2 = rsqrtf(wave_sum(ss2) * (1.f / DM) + EPS);
            const float* md1 = MODW + (size_t)(9 + mrow) * 3072;
#pragma unroll
            for (int j = 0; j < 4; ++j) {
                const int c = lane * 4 + 256 * j;
                const float4 g = *(const float4*)(p->in[I_GPRE] + DM + c), sh = *(const float4*)(md1 + c), scl = *(const float4*)(md1 + 1024 + c);
                u32x2 o;
                o.x = pk2(x[j].x * rstd2 * g.x * (1.f + scl.x) + sh.x, x[j].y * rstd2 * g.y * (1.f + scl.y) + sh.y);
                o.y = pk2(x[j].z * rstd2 * g.z * (1.f + scl.z) + sh.z, x[j].w * rstd2 * g.w * (1.f + scl.w) + sh.w);
                *(u32x2*)(H + (size_t)row * DM + c) = o;
            }
        }
    }
}

typedef __attribute__((address_space(3))) unsigned* lds_u32p;
__device__ __forceinline__ void dma16(const void* g, void* l) { __builtin_amdgcn_global_load_lds((const unsigned*)g, (lds_u32p)l, 16, 0, 0); }

__device__ __forceinline__ void gemm_phase(const u16* __restrict__ A, const u16* __restrict__ BT, int ntn, u16* __restrict__ C, int ldc, int tail16, unsigned char* smem) {
    const int tid = opaque_tid(), lane = tid & 63, w = __builtin_amdgcn_readfirstlane(tid >> 6), wm = w >> 2, wn = w & 3, fr = lane & 15, quad = lane >> 4;
    const int lrow = tid >> 3, lch = tid & 7, gch = lch ^ ((lrow >> 1) & 7);
    unsigned char* As = smem;
    unsigned char* Bs = smem + 65536;
    const int xcd = blockIdx.x & 7, jloc = blockIdx.x >> 3, nloc = gridDim.x >> 3, per_x = 8 * ntn;
    for (int tl = jloc; tl < per_x; tl += nloc) {
        const int mt_ = xcd * 8 + (tl & 7), nt_ = tl >> 3, m0 = mt_ * 256, n0 = nt_ * 256;
        const u16* gA = A + (size_t)(m0 + lrow) * DM + gch * 8;
        const u16* gB = BT + (size_t)(n0 + lrow) * DM + gch * 8;
        f32x4 acc[8][4];
#pragma unroll
        for (int i = 0; i < 8; ++i)
#pragma unroll
            for (int j = 0; j < 4; ++j) acc[i][j] = (f32x4){0.f, 0.f, 0.f, 0.f};
#pragma unroll
        for (int i = 0; i < 4; ++i) { dma16(gA + (size_t)i * 64 * DM, As + i * 8192 + tid * 16); dma16(gB + (size_t)i * 64 * DM, Bs + i * 8192 + tid * 16); }
        __syncthreads();
        for (int kt = 0; kt < 16; ++kt) {
            const int buf = kt & 1;
            if (kt < 15) {
#pragma unroll
                for (int i = 0; i < 4; ++i) {
                    dma16(gA + (size_t)i * 64 * DM + (kt + 1) * 64, As + (buf ^ 1) * 32768 + i * 8192 + tid * 16);
                    dma16(gB + (size_t)i * 64 * DM + (kt + 1) * 64, Bs + (buf ^ 1) * 32768 + i * 8192 + tid * 16);
                }
            }
            const unsigned char* Ab = As + buf * 32768; const unsigned char* Bb = Bs + buf * 32768;
#pragma unroll
            for (int ks = 0; ks < 2; ++ks) {
                bf16x8 bfr[4];
#pragma unroll
                for (int j = 0; j < 4; ++j) bfr[j] = *(const bf16x8*)(Bb + swz(wn * 64 + j * 16 + fr, ks * 4 + quad));
#pragma unroll
                for (int ih = 0; ih < 2; ++ih) {
                    bf16x8 af[4];
#pragma unroll
                    for (int i = 0; i < 4; ++i) af[i] = *(const bf16x8*)(Ab + swz(wm * 128 + (ih * 4 + i) * 16 + fr, ks * 4 + quad));
#pragma unroll
                    for (int i = 0; i < 4; ++i)
#pragma unroll
                        for (int j = 0; j < 4; ++j) acc[ih * 4 + i][j] = mfma16(bfr[j], af[i], acc[ih * 4 + i][j]);
                }
            }
            __syncthreads();
        }
#pragma unroll
        for (int i = 0; i < 8; ++i)
#pragma unroll
            for (int jp = 0; jp < 2; ++jp) {
                const unsigned ax = pk2(acc[i][2 * jp][0], acc[i][2 * jp][1]), ay = pk2(acc[i][2 * jp][2], acc[i][2 * jp][3]);
                const unsigned bx = pk2(acc[i][2 * jp + 1][0], acc[i][2 * jp + 1][1]), by = pk2(acc[i][2 * jp + 1][2], acc[i][2 * jp + 1][3]);
                const auto sx = __builtin_amdgcn_permlane16_swap(ax, bx, false, false);
                const auto sy = __builtin_amdgcn_permlane16_swap(ay, by, false, false);
                const int row = m0 + wm * 128 + i * 16 + fr;
                const int col = n0 + wn * 64 + ((quad & 1) ? (2 * jp + 1) * 16 + (quad - 1) * 4 : (2 * jp) * 16 + quad * 4);
                *(u32x4*)(C + (size_t)row * ldc + col) = (u32x4){sx[0], sy[0], sx[1], sy[1]};
            }
    }
    if (tail16 > 0) {
        const int ntask = 1024 * tail16;
        for (int task = blockIdx.x * 8 + w; task < ntask; task += gridDim.x * 8) {
            const int mt16 = task / tail16, nt16 = task % tail16, col0 = ntn * 256 + nt16 * 16;
            const u16* ap = A + (size_t)(mt16 * 16 + fr) * DM + quad * 8;
            const u16* bp = BT + (size_t)(col0 + fr) * DM + quad * 8;
            f32x4 acc = (f32x4){0.f, 0.f, 0.f, 0.f};
#pragma unroll 8
            for (int ks = 0; ks < 32; ++ks) acc = mfma16(*(const bf16x8*)(bp + ks * 32), *(const bf16x8*)(ap + ks * 32), acc);
            u32x2 o; o.x = pk2(acc[0], acc[1]); o.y = pk2(acc[2], acc[3]);
            *(u32x2*)(C + (size_t)(mt16 * 16 + fr) * ldc + col0 + quad * 4) = o;
        }
    }
}

__device__ __forceinline__ float log_sigmoid_f(float x) { return fminf(x, 0.f) - __logf(1.f + __expf(-fabsf(x))); }
__device__ __forceinline__ void unpack8(u32x4 r, float (&v)[8]) {
    v[0] = bflo(r.x); v[1] = bfhi(r.x); v[2] = bflo(r.y); v[3] = bfhi(r.y); v[4] = bflo(r.z); v[5] = bfhi(r.z); v[6] = bflo(r.w); v[7] = bfhi(r.w);
}
__device__ __forceinline__ u32x4 pack8(const float (&v)[8]) { u32x4 o; o.x = pk2(v[0], v[1]); o.y = pk2(v[2], v[3]); o.z = pk2(v[4], v[5]); o.w = pk2(v[6], v[7]); return o; }
__device__ __forceinline__ void store8f(float* d, const float (&v)[8]) { *(float4*)d = make_float4(v[0], v[1], v[2], v[3]); *(float4*)(d + 4) = make_float4(v[4], v[5], v[6], v[7]); }
__device__ __forceinline__ void vt_store(u16* Tl, u32x4 raw, int tok_l, int sub, u16* vt_base, int rowlen, int tcol0) {
    const int tid = vtid();
    Tl[(sub * 8 + 0) * 40 + tok_l] = (u16)(raw.x & 0xffff); Tl[(sub * 8 + 1) * 40 + tok_l] = (u16)(raw.x >> 16);
    Tl[(sub * 8 + 2) * 40 + tok_l] = (u16)(raw.y & 0xffff); Tl[(sub * 8 + 3) * 40 + tok_l] = (u16)(raw.y >> 16);
    Tl[(sub * 8 + 4) * 40 + tok_l] = (u16)(raw.z & 0xffff); Tl[(sub * 8 + 5) * 40 + tok_l] = (u16)(raw.z >> 16);
    Tl[(sub * 8 + 6) * 40 + tok_l] = (u16)(raw.w & 0xffff); Tl[(sub * 8 + 7) * 40 + tok_l] = (u16)(raw.w >> 16);
    __syncthreads();
    const int d = tid >> 2, part = tid & 3;
    const u32x2 pa = *(const u32x2*)(Tl + d * 40 + part * 4), pb = *(const u32x2*)(Tl + d * 40 + 16 + part * 4);
    *(u32x4*)(vt_base + (size_t)d * rowlen + tcol0 + part * 8) = (u32x4){pa.x, pa.y, pb.x, pb.y};
    __syncthreads();
}

__device__ void post_phase(PP p, int l, unsigned char* smem) {
    const int tid = vtid(), tok_l = tid >> 3, sub = tid & 7, hb = half_id();
    u16* Tl = (u16*)smem;
    u16* Z = (u16*)(p->ws + WS_Z);
    u16* KA = (u16*)(p->ws + WS_KA); u16* VAT = (u16*)(p->ws + WS_VAT);
    u16* KB = (u16*)(p->ws + WS_KB); u16* VBT = (u16*)(p->ws + WS_VBT); u16* CVT = (u16*)(p->ws + WS_CVT);
    const float2* tab = (const float2*)(smem + 8192);
    const float* gwL = (const float*)(smem + 16384);
    const float* gbL = (const float*)(smem + 32768);
    {
        const float2* tabg = (const float2*)(p->ws + WS_ROPE);
        for (int i = tid; i < 1024; i += VT) ((float2*)(smem + 8192))[i] = tabg[i];
        for (int i = tid; i < 4096; i += VT) ((float*)(smem + 16384))[i] = ((i >> 11) ? p->in[I_CWB] : p->in[I_CWF])[l * 2048 + (i & 2047)];
        if (tid < 256) ((float*)(smem + 32768))[tid] = ((tid >> 7) ? p->in[I_CBB] : p->in[I_CBF])[l * 128 + (tid & 127)];
    }
    float gq[8], gk[8];
#pragma unroll
    for (int i = 0; i < 8; ++i) { gq[i] = p->in[I_AQG][l * 64 + sub * 8 + i]; gk[i] = p->in[I_AKG][l * 64 + sub * 8 + i]; }
    __syncthreads();
    for (int it0 = blockIdx.x * 2; it0 < 512 + 768; it0 += gridDim.x * 2) {
        const int it = it0 + hb;
        asm volatile("" : "+s"(p));
        if (it < 512) {
            const int tok0 = it * 32, grp = tok0 >= 8192;
            const int b = grp ? (tok0 - 8192) >> 10 : tok0 >> 8, t0 = grp ? (tok0 - 8192) & 1023 : tok0 & 255;
            const int tok = tok0 + tok_l, t = t0 + tok_l;
            const int Lk = grp ? 1280 : 256, kof = grp ? 256 : 0;
            const int prow = t >> 6, pcol = t & 63;
            u32x4 raw_next = *(const u32x4*)(Z + (size_t)tok * NIN + sub * 8);
            for (int u = 0; u < 28; ++u) {
                const int col0 = u < 24 ? u * 64 : 1792 + (u - 24) * 64;
                u16* zp = Z + (size_t)tok * NIN + col0 + sub * 8;
                u32x4 raw = raw_next;
                if (u + 1 < 28) { const int coln = (u + 1) < 24 ? (u + 1) * 64 : 1792 + (u + 1 - 24) * 64; raw_next = *(const u32x4*)(Z + (size_t)tok * NIN + coln + sub * 8); }
                if (u < 10) {
                    float v[8]; unpack8(raw, v);
                    float ss = 0.f;
#pragma unroll
                    for (int i = 0; i < 8; ++i) ss += v[i] * v[i];
                    ss = sum8(ss);
                    const float rstd = rsqrtf(ss * (1.f / 64.f) + EPS);
#pragma unroll
                    for (int i = 0; i < 8; ++i) v[i] = v[i] * rstd * (u < 8 ? gq[i] : gk[i]);
                    if (u >= 8 && !grp) store8f(p->out + OUT_AK + ((size_t)((b * 2 + l) * 2 + (u - 8)) * 256 + t) * 64 + sub * 8, v);
                    if (grp) {
                        const int pos = (sub & 4) ? pcol : prow;
#pragma unroll
                        for (int i = 0; i < 8; ++i) {
                            const float pr = xor2f(v[i]);
                            const float2 cs = tab[pos * 16 + (sub & 1) * 8 + i];
                            v[i] = (sub & 2) ? v[i] * cs.x + pr * cs.y : v[i] * cs.x - pr * cs.y;
                        }
                    }
                    const u32x4 o = pack8(v);
                    if (u < 8) *(u32x4*)zp = o;
                    else *(u32x4*)(KA + kv_off(grp, b, u - 8, 2, 1280) + (size_t)(kof + t) * 64 + sub * 8) = o;
                } else if (u < 12) {
                    const int kvh = u - 10;
                    if (!grp) { float v[8]; unpack8(raw, v); store8f(p->out + OUT_AV + ((size_t)((b * 2 + l) * 2 + kvh) * 256 + t) * 64 + sub * 8, v); }
                    vt_store(Tl, raw, tok_l, sub, VAT + kv_off(grp, b, kvh, 2, 1280), Lk, kof + t0);
                } else if (u < 20) {
                    const int isk = u >= 16, h = isk ? u - 16 : u - 12;
                    float v[8]; unpack8(raw, v);
                    if (isk && !grp) store8f(p->out + OUT_BK + ((size_t)((b * 2 + l) * 4 + h) * 256 + t) * 64 + sub * 8, v);
                    if (grp) {
                        const int pos = (sub & 2) ? pcol : prow;
#pragma unroll
                        for (int i = 0; i < 8; ++i) {
                            const float pr = xor1f(v[i]);
                            const float2 cs = tab[pos * 16 + 2 * i];
                            v[i] = (sub & 1) ? v[i] * cs.x + pr * cs.y : v[i] * cs.x - pr * cs.y;
                        }
                        raw = pack8(v);
                    }
                    if (!isk) { if (grp) *(u32x4*)zp = raw; }
                    else *(u32x4*)(KB + kv_off(grp, b, h, 4, 1280) + (size_t)(kof + t) * 64 + sub * 8) = raw;
                } else if (u < 24) {
                    const int h = u - 20;
                    if (!grp) { float v[8]; unpack8(raw, v); store8f(p->out + OUT_BV + ((size_t)((b * 2 + l) * 4 + h) * 256 + t) * 64 + sub * 8, v); }
                    vt_store(Tl, raw, tok_l, sub, VBT + kv_off(grp, b, h, 4, 1280), Lk, kof + t0);
                } else {
                    const int h = u - 24;
                    vt_store(Tl, raw, tok_l, sub, CVT + kv_off(grp, b, h, 4, 1024), grp ? 1024 : 256, t0);
                }
            }
            {
                const int dir = sub >> 2, c0 = (sub & 3) * 32;
                float lr[16];
                { float t8[8];
                  unpack8(*(const u32x4*)(Z + (size_t)tok * NIN + 2048 + dir * 16), t8);
#pragma unroll
                  for (int i = 0; i < 8; ++i) lr[i] = t8[i];
                  unpack8(*(const u32x4*)(Z + (size_t)tok * NIN + 2048 + dir * 16 + 8), t8);
#pragma unroll
                  for (int i = 0; i < 8; ++i) lr[8 + i] = t8[i]; }
                const float* gw = gwL + dir * 2048 + c0;
                const float* gb = gbL + dir * 128 + c0;
                float* gout = (float*)(p->ws + WS_G) + (size_t)tok * 256 + dir * 128 + c0;
#pragma unroll 1
                for (int cc = 0; cc < 8; ++cc) {
                    float4 a = *(const float4*)(gb + cc * 4);
#pragma unroll
                    for (int r = 0; r < 16; ++r) { const float4 w4 = *(const float4*)(gw + r * 128 + cc * 4); a.x += lr[r] * w4.x; a.y += lr[r] * w4.y; a.z += lr[r] * w4.z; a.w += lr[r] * w4.w; }
                    a.x = log_sigmoid_f(a.x) * (1.f / 16.f); a.y = log_sigmoid_f(a.y) * (1.f / 16.f); a.z = log_sigmoid_f(a.z) * (1.f / 16.f); a.w = log_sigmoid_f(a.w) * (1.f / 16.f);
                    *(float4*)(gout + cc * 4) = a;
                }
            }
        } else {
            const int idx = it - 512, cu = idx % 12, rest = idx / 12, ktile = rest & 7, b = rest >> 3;
            const int key0 = ktile * 32, key = key0 + tok_l;
            const float* src; int hh, H;
            if (cu < 2) { hh = cu; H = 2; src = p->in[I_CAK]; } else if (cu < 4) { hh = cu - 2; H = 2; src = p->in[I_CAV]; }
            else if (cu < 8) { hh = cu - 4; H = 4; src = p->in[I_CBK]; } else { hh = cu - 8; H = 4; src = p->in[I_CBV]; }
            const float* sp = src + ((size_t)((b * 2 + l) * H + hh) * 256 + key) * 64 + sub * 8;
            const float4 a0 = *(const float4*)sp, a1 = *(const float4*)(sp + 4);
            u32x4 o; o.x = pk2(a0.x, a0.y); o.y = pk2(a0.z, a0.w); o.z = pk2(a1.x, a1.y); o.w = pk2(a1.z, a1.w);
            if (cu < 2) *(u32x4*)(KA + kv_off(1, b, hh, 2, 1280) + (size_t)key * 64 + sub * 8) = o;
            else if (cu < 4) vt_store(Tl, o, tok_l, sub, VAT + kv_off(1, b, hh, 2, 1280), 1280, key0);
            else if (cu < 8) *(u32x4*)(KB + kv_off(1, b, hh, 4, 1280) + (size_t)key * 64 + sub * 8) = o;
            else vt_store(Tl, o, tok_l, sub, VBT + kv_off(1, b, hh, 4, 1280), 1280, key0);
        }
    }
}

__device__ __forceinline__ float quad_max(float v) {
    unsigned u = __float_as_uint(v);
    auto r = __builtin_amdgcn_permlane16_swap(u, u, false, false);
    v = fmaxf(__uint_as_float(r[0]), __uint_as_float(r[1]));
    u = __float_as_uint(v);
    auto r2 = __builtin_amdgcn_permlane32_swap(u, u, false, false);
    return fmaxf(__uint_as_float(r2[0]), __uint_as_float(r2[1]));
}

template <int NP>
__device__ __forceinline__ void attn_sweep(const u16* __restrict__ Kg, const u16* __restrict__ Vg, int Lk, const bf16x8 (&qf)[2][2], unsigned char* smem, f32x4 (&O)[NP][4][2]) {
    const int tid = vtid(), lane = tid & 63, fr = lane & 15, quad = lane >> 4;
    float mrun[NP][2]; f32x4 Lacc[NP][2];
#pragma unroll
    for (int pp = 0; pp < NP; ++pp)
#pragma unroll
        for (int qs = 0; qs < 2; ++qs) {
            mrun[pp][qs] = -INFINITY; Lacc[pp][qs] = (f32x4){0.f, 0.f, 0.f, 0.f};
#pragma unroll
            for (int dt = 0; dt < 4; ++dt) O[pp][dt][qs] = (f32x4){0.f, 0.f, 0.f, 0.f};
        }
    unsigned char* Ks = smem;
    unsigned char* Vs = smem + 16384;
    const int t512 = opaque_tid(), lrow = t512 >> 3, lch = t512 & 7;
    u32x4 rk, rv;
    rk = *(const u32x4*)(Kg + (size_t)lrow * 64 + lch * 8); rv = *(const u32x4*)(Vg + (size_t)lrow * Lk + lch * 8);
    *(u32x4*)(Ks + swz(lrow, lch)) = rk; *(u32x4*)(Vs + swz(lrow, lch)) = rv;
    __syncthreads();
    const int ntile = Lk >> 6;
    for (int t = 0; t < ntile; ++t) {
        const int buf = t & 1;
        if (t + 1 < ntile) {
            rk = *(const u32x4*)(Kg + (size_t)((t + 1) * 64 + lrow) * 64 + lch * 8);
            rv = *(const u32x4*)(Vg + (size_t)lrow * Lk + (t + 1) * 64 + lch * 8);
        }
        const unsigned char* Kb = Ks + buf * 8192; const unsigned char* Vb = Vs + buf * 8192;
#pragma unroll
        for (int pp = 0; pp < NP; ++pp) {
            f32x4 S[4][2];
#pragma unroll
            for (int kt = 0; kt < 4; ++kt) { S[kt][0] = (f32x4){0.f, 0.f, 0.f, 0.f}; S[kt][1] = (f32x4){0.f, 0.f, 0.f, 0.f}; }
#pragma unroll
            for (int kt = 0; kt < 4; ++kt)
#pragma unroll
                for (int ks = (NP == 2 ? pp : 0); ks < (NP == 2 ? pp + 1 : 2); ++ks) {
                    const bf16x8 kf = *(const bf16x8*)(Kb + swz(kt * 16 + fr, ks * 4 + quad));
                    S[kt][0] = mfma16(kf, qf[0][ks], S[kt][0]);
                    S[kt][1] = mfma16(kf, qf[1][ks], S[kt][1]);
                }
            bf16x8 pf[2][2];
#pragma unroll
            for (int qs = 0; qs < 2; ++qs) {
                float mx = -INFINITY;
#pragma unroll
                for (int kt = 0; kt < 4; ++kt)
#pragma unroll
                    for (int r = 0; r < 4; ++r) mx = fmaxf(mx, S[kt][qs][r]);
                mx = quad_max(mx);
                const float mold = mrun[pp][qs];
                const float mnew = fmaxf(mold, mx);
                mrun[pp][qs] = mnew;
                const f32x4 mv = (f32x4){mnew, mnew, mnew, mnew};
#pragma unroll
                for (int kt = 0; kt < 4; ++kt) {
                    const f32x4 d = S[kt][qs] - mv;
                    f32x4 e; e[0] = fast_exp2(d[0]); e[1] = fast_exp2(d[1]); e[2] = fast_exp2(d[2]); e[3] = fast_exp2(d[3]);
                    S[kt][qs] = e;
                }
                if (__builtin_amdgcn_ballot_w64(mnew != mold) != 0ull) {
                    const float alpha = fast_exp2(mold - mnew);
                    Lacc[pp][qs] *= alpha;
#pragma unroll
                    for (int dt = 0; dt < 4; ++dt) O[pp][dt][qs] *= alpha;
                }
#pragma unroll
                for (int kb = 0; kb < 2; ++kb) {
                    u32x4 pk; pk.x = pk2(S[2 * kb][qs][0], S[2 * kb][qs][1]); pk.y = pk2(S[2 * kb][qs][2], S[2 * kb][qs][3]);
                    pk.z = pk2(S[2 * kb + 1][qs][0], S[2 * kb + 1][qs][1]); pk.w = pk2(S[2 * kb + 1][qs][2], S[2 * kb + 1][qs][3]);
                    pf[qs][kb] = as_bf8(pk);
                }
            }
#pragma unroll
            for (int dt = 0; dt < 4; ++dt)
#pragma unroll
                for (int kb = 0; kb < 2; ++kb) {
                    const int row = dt * 16 + fr;
                    const bf16x8 vf = *(const bf16x8*)(Vb + swz(row, kb * 4 + quad));
                    O[pp][dt][0] = mfma16(vf, pf[0][kb], O[pp][dt][0]);
                    O[pp][dt][1] = mfma16(vf, pf[1][kb], O[pp][dt][1]);
                }
            {
                const bf16x8 ones = as_bf8((u32x4){0x3F803F80u, 0x3F803F80u, 0x3F803F80u, 0x3F803F80u});
#pragma unroll
                for (int kb = 0; kb < 2; ++kb) { Lacc[pp][0] = mfma16(ones, pf[0][kb], Lacc[pp][0]); Lacc[pp][1] = mfma16(ones, pf[1][kb], Lacc[pp][1]); }
            }
        }
        if (t + 1 < ntile) { *(u32x4*)(Ks + (buf ^ 1) * 8192 + swz(lrow, lch)) = rk; *(u32x4*)(Vs + (buf ^ 1) * 8192 + swz(lrow, lch)) = rv; }
        __syncthreads();
    }
#pragma unroll
    for (int pp = 0; pp < NP; ++pp)
#pragma unroll
        for (int qs = 0; qs < 2; ++qs) {
            const float lt = Lacc[pp][qs][0];
            const float inv = __builtin_amdgcn_rcpf(lt);
#pragma unroll
            for (int dt = 0; dt < 4; ++dt) O[pp][dt][qs] *= inv;
        }
}

template <int MODE>
__device__ void attn_item(PP p, int l, int grp, int b, int head, int qb, unsigned char* smem_blk) {
    const int tid = vtid(), lane = tid & 63, w = __builtin_amdgcn_readfirstlane(tid >> 6), fr = lane & 15, quad = lane >> 4;
    const int Lk = grp ? 1280 : 256;
    const int tokbase = grp ? 8192 + b * 1024 : b * 256;
    const u16* Z = (const u16*)(p->ws + WS_Z);
    u16* MIX = (u16*)(p->ws + WS_MIX);
    const int qcol = MODE ? 768 + head * 64 : head * 64;
    const int mcol = MODE ? 512 + head * 64 : head * 64;
    const u16* Kg = MODE ? (const u16*)(p->ws + WS_KB) + kv_off(grp, b, head, 4, 1280) : (const u16*)(p->ws + WS_KA) + kv_off(grp, b, head >> 2, 2, 1280);
    const u16* Vg = MODE ? (const u16*)(p->ws + WS_VBT) + kv_off(grp, b, head, 4, 1280) : (const u16*)(p->ws + WS_VAT) + kv_off(grp, b, head >> 2, 2, 1280);
    const float cscale = (MODE ? 0.17677669529663687f : 0.125f) * 1.4426950408889634f;

    bf16x8 qf[2][2];
#pragma unroll
    for (int qs = 0; qs < 2; ++qs)
#pragma unroll
        for (int ks = 0; ks < 2; ++ks)
            {
                const u32x4 raw = *(const u32x4*)(Z + (size_t)(tokbase + qb * 128 + w * 32 + qs * 16 + fr) * NIN + qcol + ks * 32 + quad * 8);
                float qv[8]; unpack8(raw, qv);
#pragma unroll
                for (int i = 0; i < 8; ++i) qv[i] *= cscale;
                qf[qs][ks] = as_bf8(pack8(qv));
            }

    f32x4 O[4][2];
    float lam = 0.f, lam_init = 0.f;
    if (MODE == 0) {
        f32x4 O1[1][4][2];
        attn_sweep<1>(Kg, Vg, Lk, qf, smem_blk, O1);
#pragma unroll
        for (int dt = 0; dt < 4; ++dt) { O[dt][0] = O1[0][dt][0]; O[dt][1] = O1[0][dt][1]; }
    } else {
        f32x4 O2[2][4][2];
        attn_sweep<2>(Kg, Vg, Lk, qf, smem_blk, O2);
        float s1 = 0.f, s2 = 0.f;
        for (int i = 0; i < 32; ++i) { s1 += p->in[I_LQ1][l * 32 + i] * p->in[I_LK1][l * 32 + i]; s2 += p->in[I_LQ2][l * 32 + i] * p->in[I_LK2][l * 32 + i]; }
        lam_init = 0.8f - 0.6f * expf(-0.3f * (float)l);
        lam = expf(s1) - expf(s2) + lam_init;
#pragma unroll
        for (int dt = 0; dt < 4; ++dt) { O[dt][0] = O2[0][dt][0] - lam * O2[1][dt][0]; O[dt][1] = O2[0][dt][1] - lam * O2[1][dt][1]; }
    }
#pragma unroll
    for (int qs = 0; qs < 2; ++qs) {
        const int tok = tokbase + qb * 128 + w * 32 + qs * 16 + fr;
        if (MODE == 1) {
            float ss = 0.f;
#pragma unroll
            for (int dt = 0; dt < 4; ++dt)
#pragma unroll
                for (int r = 0; r < 4; ++r) ss += O[dt][qs][r] * O[dt][qs][r];
            ss = rows_sum(ss);
            const float rstd = rsqrtf(ss * (1.f / 64.f) + EPS) * (1.f - lam_init);
#pragma unroll
            for (int dt = 0; dt < 4; ++dt) {
                const f32x4 g4 = *(const f32x4*)(p->in[I_BOG] + l * 64 + dt * 16 + quad * 4);
                O[dt][qs] *= g4 * rstd;
            }
        }
#pragma unroll
        for (int dt = 0; dt < 4; ++dt) {
            const int col = mcol + dt * 16 + quad * 4;
            const u32x2 ur = *(const u32x2*)(Z + (size_t)tok * NIN + 2080 + col);
            u32x2 ov;
            ov.x = pk2(O[dt][qs][0] * silu_f(bflo(ur.x)), O[dt][qs][1] * silu_f(bfhi(ur.x)));
            ov.y = pk2(O[dt][qs][2] * silu_f(bflo(ur.y)), O[dt][qs][3] * silu_f(bfhi(ur.y)));
            *(u32x2*)(MIX + (size_t)tok * DM + col) = ov;
        }
    }
    __syncthreads();
}


__device__ void gla_item(PP p, int l, int grp, int b, int h, int dir, unsigned char* smem) {
    const int tid = vtid(), lane = tid & 63, w = __builtin_amdgcn_readfirstlane(tid >> 6), fr = lane & 15, quad = lane >> 4;
    const int L = grp ? 1024 : 256, nch = L >> 6;
    const int tokbase = grp ? 8192 + b * 1024 : b * 256;
    const u16* Z = (const u16*)(p->ws + WS_Z);
    u16* MIX = (u16*)(p->ws + WS_MIX);
    float* OC = (float*)(p->ws + (dir ? WS_H : WS_OC));
    const u16* Vt = (const u16*)(p->ws + WS_CVT) + kv_off(grp, b, h, 4, 1024);
    u16* QtL = (u16*)smem;
    u16* KtL = (u16*)(smem + 5120);
    u16* KlT = (u16*)(smem + 10240);
    float* Dl = (float*)(smem + 14848);
    const float qscale = 0.17677669529663687f;

    {
        f32x4 Sacc[2][4];
        const float* s0 = (dir ? p->in[I_SCB] : p->in[I_SCF]) + (size_t)((b * 2 + l) * 4 + h) * 32 * 64;
#pragma unroll
        for (int dt = 0; dt < 2; ++dt)
#pragma unroll
            for (int et = 0; et < 4; ++et)
#pragma unroll
                for (int r = 0; r < 4; ++r) Sacc[dt][et][r] = grp ? s0[(dt * 16 + quad * 4 + r) * 64 + et * 16 + fr] : 0.f;
        float4 ng0, ng1; u32x4 nq, nk;
        {
            const int c0 = dir ? nch - 1 : 0;
            const float* gp = (const float*)(p->ws + WS_G) + (size_t)(tokbase + c0 * 64 + lane) * 256 + dir * 128 + h * 32 + 8 * w;
            ng0 = *(const float4*)gp; ng1 = *(const float4*)(gp + 4);
            const size_t zrow = (size_t)(tokbase + c0 * 64 + lane) * NIN;
            nq = *(const u32x4*)(Z + zrow + 1536 + h * 32 + 8 * w); nk = *(const u32x4*)(Z + zrow + 1664 + h * 32 + 8 * w);
        }
        for (int ci = 0; ci < nch; ++ci) {
            const int c = dir ? nch - 1 - ci : ci, t0 = c * 64;
            const float4 g0 = ng0, g1 = ng1; const u32x4 cq = nq, ck = nk;
            bf16x8 vfr[4][2];
#pragma unroll
            for (int et = 0; et < 4; ++et)
#pragma unroll
                for (int jb = 0; jb < 2; ++jb) {
                    vfr[et][jb] = *(const bf16x8*)(Vt + (size_t)(et * 16 + fr) * L + t0 + jb * 32 + quad * 8);
                }
            if (ci + 1 < nch) {
                const int cn = dir ? nch - 2 - ci : ci + 1;
                const float* gp = (const float*)(p->ws + WS_G) + (size_t)(tokbase + cn * 64 + lane) * 256 + dir * 128 + h * 32 + 8 * w;
                ng0 = *(const float4*)gp; ng1 = *(const float4*)(gp + 4);
                const size_t zrow = (size_t)(tokbase + cn * 64 + lane) * NIN;
                nq = *(const u32x4*)(Z + zrow + 1536 + h * 32 + 8 * w); nk = *(const u32x4*)(Z + zrow + 1664 + h * 32 + 8 * w);
            }
            {
                float q[8], k[8], g[8], pre[8];
                g[0] = g0.x; g[1] = g0.y; g[2] = g0.z; g[3] = g0.w; g[4] = g1.x; g[5] = g1.y; g[6] = g1.z; g[7] = g1.w;
#pragma unroll
                for (int dd = 0; dd < 8; ++dd) pre[dd] = g[dd];
                unpack8(cq, q);
                unpack8(ck, k);
#pragma unroll
                for (int off = 1; off < 64; off <<= 1)
#pragma unroll
                    for (int dd = 0; dd < 8; ++dd) { const float tv = __shfl_up(pre[dd], off); if (lane >= off) pre[dd] += tv; }
                float qt[8], kt8[8];
#pragma unroll
                for (int dd = 0; dd < 8; ++dd) {
                    const float tot = __shfl(pre[dd], 63);
                    const float cum = dir ? (tot - pre[dd] + g[dd]) : pre[dd];
                    qt[dd] = q[dd] * qscale * __expf(cum);
                    kt8[dd] = k[dd] * __expf(-cum);
                    const float kl = k[dd] * __expf(tot - cum);
                    KlT[(8 * w + dd) * 72 + lane] = (u16)(pk2(kl, 0.f) & 0xffff);
                    if (lane == 0) Dl[8 * w + dd] = __expf(tot);
                }
                *(u32x4*)(QtL + lane * 40 + 8 * w) = pack8(qt);
                *(u32x4*)(KtL + lane * 40 + 8 * w) = pack8(kt8);
            }
            __syncthreads();
            const bf16x8 qstd = *(const bf16x8*)(QtL + (16 * w + fr) * 40 + quad * 8);
            f32x4 PT[4];
#pragma unroll
            for (int jt = 0; jt < 4; ++jt) {
                PT[jt] = (f32x4){0.f, 0.f, 0.f, 0.f};
                const bool need = dir ? (jt >= w) : (jt <= w);
                if (need) {
                    const bf16x8 kfr = *(const bf16x8*)(KtL + (jt * 16 + fr) * 40 + quad * 8);
                    PT[jt] = mfma16(kfr, qstd, PT[jt]);
                    if (jt == w) {
#pragma unroll
                        for (int r = 0; r < 4; ++r) { const int jj = quad * 4 + r; const bool keep = dir ? (jj >= fr) : (jj <= fr); if (!keep) PT[jt][r] = 0.f; }
                    }
                }
            }
            bf16x8 pa[2];
#pragma unroll
            for (int jb = 0; jb < 2; ++jb) {
                u32x4 pk; pk.x = pk2(PT[2 * jb][0], PT[2 * jb][1]); pk.y = pk2(PT[2 * jb][2], PT[2 * jb][3]);
                pk.z = pk2(PT[2 * jb + 1][0], PT[2 * jb + 1][1]); pk.w = pk2(PT[2 * jb + 1][2], PT[2 * jb + 1][3]);
                pa[jb] = as_bf8(pk);
            }
            bf16x8 qrel;
            {
                const u32x2 a = *(const u32x2*)(QtL + (16 * w + fr) * 40 + quad * 4), a2 = *(const u32x2*)(QtL + (16 * w + fr) * 40 + 16 + quad * 4);
                qrel = as_bf8((u32x4){a.x, a.y, a2.x, a2.y});
            }
            f32x4 Oacc[4];
#pragma unroll
            for (int et = 0; et < 4; ++et) {
                Oacc[et] = (f32x4){0.f, 0.f, 0.f, 0.f};
                Oacc[et] = mfma16(pa[0], vfr[et][0], Oacc[et]);
                Oacc[et] = mfma16(pa[1], vfr[et][1], Oacc[et]);
                u32x4 sb; sb.x = pk2(Sacc[0][et][0], Sacc[0][et][1]); sb.y = pk2(Sacc[0][et][2], Sacc[0][et][3]);
                sb.z = pk2(Sacc[1][et][0], Sacc[1][et][1]); sb.w = pk2(Sacc[1][et][2], Sacc[1][et][3]);
                Oacc[et] = mfma16(qrel, as_bf8(sb), Oacc[et]);
            }
#pragma unroll
            for (int dt = 0; dt < 2; ++dt) {
                bf16x8 klf[2];
#pragma unroll
                for (int jb = 0; jb < 2; ++jb) {
                    const u32x2 a = *(const u32x2*)(KlT + (dt * 16 + fr) * 72 + jb * 32 + quad * 4), a2 = *(const u32x2*)(KlT + (dt * 16 + fr) * 72 + jb * 32 + 16 + quad * 4);
                    klf[jb] = as_bf8((u32x4){a.x, a.y, a2.x, a2.y});
                }
                float dec[4];
#pragma unroll
                for (int r = 0; r < 4; ++r) dec[r] = Dl[dt * 16 + quad * 4 + r];
#pragma unroll
                for (int et = 0; et < 4; ++et) {
                    f32x4 hacc;
#pragma unroll
                    for (int r = 0; r < 4; ++r) hacc[r] = dec[r] * Sacc[dt][et][r];
                    hacc = mfma16(klf[0], vfr[et][0], hacc);
                    hacc = mfma16(klf[1], vfr[et][1], hacc);
                    Sacc[dt][et] = hacc;
                }
            }
#pragma unroll
            for (int r = 0; r < 4; ++r) {
                const int tok = tokbase + t0 + 16 * w + quad * 4 + r;
                float* ocp = OC + (size_t)tok * 256 + h * 64 + fr;
#pragma unroll
                for (int et = 0; et < 4; ++et) ocp[et * 16] = Oacc[et][r];
            }
            __syncthreads();
        }
        if (!grp && w == 0) {
            float* so = p->out + (dir ? OUT_SB : OUT_SF) + (size_t)((b * 2 + l) * 4 + h) * 32 * 64;
#pragma unroll
            for (int dt = 0; dt < 2; ++dt)
#pragma unroll
                for (int et = 0; et < 4; ++et)
#pragma unroll
                    for (int r = 0; r < 4; ++r) so[(dt * 16 + quad * 4 + r) * 64 + et * 16 + fr] = Sacc[dt][et][r];
        }
        __syncthreads();
    }
}

__device__ __forceinline__ void gla_combine(PP p, int l, int grp, int b, int h) {
    const int tid = opaque_tid(), l16 = tid & 15, rowl = tid >> 4;
    const int L = grp ? 1024 : 256, tokbase = grp ? 8192 + b * 1024 : b * 256;
    const float* OCf = (const float*)(p->ws + WS_OC);
    const float* OCb = (const float*)(p->ws + WS_H);
    const u16* Z = (const u16*)(p->ws + WS_Z);
    u16* MIX = (u16*)(p->ws + WS_MIX);
    const float4 g = *(const float4*)(p->in[I_COG] + l * 64 + l16 * 4);
#pragma unroll 4
    for (int r0 = 0; r0 < L; r0 += 32) {
        const size_t tok = (size_t)(tokbase + r0 + rowl);
        const float4 a = *(const float4*)(OCf + tok * 256 + h * 64 + l16 * 4), c = *(const float4*)(OCb + tok * 256 + h * 64 + l16 * 4);
        const float o0 = a.x + c.x, o1 = a.y + c.y, o2 = a.z + c.z, o3 = a.w + c.w;
        float ss = o0 * o0 + o1 * o1 + o2 * o2 + o3 * o3;
        ss = sum16(ss);
        const float rstd = rsqrtf(ss * (1.f / 64.f) + EPS);
        const u32x2 ur = *(const u32x2*)(Z + tok * NIN + 2080 + 768 + h * 64 + l16 * 4);
        u32x2 ov;
        ov.x = pk2(o0 * rstd * g.x * silu_f(bflo(ur.x)), o1 * rstd * g.y * silu_f(bfhi(ur.x)));
        ov.y = pk2(o2 * rstd * g.z * silu_f(bflo(ur.y)), o3 * rstd * g.w * silu_f(bfhi(ur.y)));
        *(u32x2*)(MIX + tok * DM + 768 + h * 64 + l16 * 4) = ov;
    }
}

__device__ void mix_phase(PP p, int l, int ctr_idx, unsigned char* smem_blk) {
    unsigned* ctr = (unsigned*)(p->ws + WS_CTR) + ctr_idx;
    volatile int* s_item = (volatile int*)(smem_blk + 65024);
    const int hb = half_id();
    unsigned char* smem = smem_blk + hb * 65536;
    for (;;) {
        if (opaque_tid() == 0) *s_item = (int)atomicAdd(ctr, 1u);
        __syncthreads();
        const int pi = __builtin_amdgcn_readfirstlane(*s_item);
        __syncthreads();
#if PROBE_DUP == 1
        if (pi >= 928 + 256) break;
        const int pj = pi < 928 ? pi : pi - 928 + 160;
#elif PROBE_DUP == 2
        if (pi >= 928 + 384) break;
        const int pj = pi < 928 ? pi : pi - 928 + 544;
#elif PROBE_DUP == 3
        if (pi >= 928 + 128) break;
        const int pj = pi < 928 ? pi : pi - 928 + 32;
#else
        if (pi >= 928) break;
        const int pj = pi;
#endif
        const int idx = 2 * pj + hb;
        asm volatile("" : "+s"(p));
        int kind, grp, b, h, qb = 0;
        if (idx < 64) { kind = 0; grp = 1; b = idx >> 3; h = (idx >> 1) & 3; qb = idx & 1; }
        else if (idx < 320) { const int j = idx - 64; kind = 1; grp = 1; b = j >> 5; h = (j >> 3) & 3; qb = j & 7; }
        else if (idx < 832) { const int j = idx - 320; kind = 2; grp = 1; b = j >> 6; h = (j >> 3) & 7; qb = j & 7; }
        else if (idx < 1088) { const int j = idx - 832; kind = 0; grp = 0; b = j >> 3; h = (j >> 1) & 3; qb = j & 1; }
        else if (idx < 1344) { const int j = idx - 1088; kind = 1; grp = 0; b = j >> 3; h = (j >> 1) & 3; qb = j & 1; }
        else { const int j = idx - 1344; kind = 2; grp = 0; b = j >> 4; h = (j >> 1) & 7; qb = j & 1; }
        if (kind == 0) { gla_item(p, l, grp, b, h, qb, smem); gla_combine(p, l, grp, b, h); }
        else if (kind == 1) attn_item<1>(p, l, grp, b, h, qb, smem_blk);
        else attn_item<0>(p, l, grp, b, h, qb, smem_blk);
    }
}

#define XB_TMO      128
#define XB_XCNT(j)  (256  + 64 * (j))
#define XB_XSUB(j)  (1280 + 64 * (j))
#define XB_XGEN(j)  (2304 + 64 * (j))
#define XB_TOP      3328
#define XB_TOPGEN   3392
#define XCD_BAR_WORDS 3456
#define XB_SPIN_CAP (1u << 18)
#define LAS __attribute__((address_space(3)))

__device__ __forceinline__ unsigned xb_ld(unsigned* p)              { return __hip_atomic_load(p, __ATOMIC_RELAXED, __HIP_MEMORY_SCOPE_AGENT); }
__device__ __forceinline__ unsigned xb_add(unsigned* p, unsigned v) { return __hip_atomic_fetch_add(p, v, __ATOMIC_RELAXED, __HIP_MEMORY_SCOPE_AGENT); }
__device__ __forceinline__ unsigned xb_xcc_id() { return (unsigned)__builtin_amdgcn_s_getreg((3 << 11) | 20) & 0xFu; }
#define XB_SPIN(cond, bar) do { unsigned _sp = 0; while (cond) { __builtin_amdgcn_s_sleep(1); \
    if ((++_sp & 255u) == 0u) { if (xb_ld(&(bar)[XB_TMO])) break; if (_sp > XB_SPIN_CAP) { atomicAdd(&(bar)[XB_TMO], 1u); break; } } } } while (0)

struct XcdBarrier {
    unsigned* bar; unsigned x;
    volatile LAS unsigned* st;
};

__device__ __forceinline__ XcdBarrier xcd_barrier_post(unsigned* bar, volatile LAS unsigned* st) {
    XcdBarrier b; b.bar = bar; b.x = xb_xcc_id(); b.st = st;
    if (threadIdx.x == 0) (void)xb_add(&bar[XB_XCNT(b.x)], 1u);
    return b;
}
__device__ __forceinline__ void xcd_barrier_complete(unsigned* bar, unsigned x, unsigned& nloc, unsigned& nx) {
    const unsigned G = gridDim.x * gridDim.y * gridDim.z;
    unsigned sum, cnt, mine, sp = 0u;
    for (;;) {
        sum = 0u; cnt = 0u; mine = 0u;
#pragma unroll
        for (unsigned j = 0; j < 16; ++j) { const unsigned c = xb_ld(&bar[XB_XCNT(j)]); sum += c; cnt += (c > 0u) ? 1u : 0u; mine = (j == x) ? c : mine; }
        if (sum == G) break;
        __builtin_amdgcn_s_sleep(1);
        if ((++sp & 255u) == 0u) { if (xb_ld(&bar[XB_TMO])) break; if (sp > XB_SPIN_CAP) { atomicAdd(&bar[XB_TMO], 1u); break; } }
    }
    nloc = mine > 0u ? mine : 1u; nx = cnt > 0u ? cnt : 1u;
}

__device__ __forceinline__ void xcd_barrier(const XcdBarrier& b) {
    asm volatile("s_waitcnt vmcnt(0)" ::: "memory");
    __syncthreads();
    if (threadIdx.x == 0) {
        unsigned* bar = b.bar;
        __builtin_amdgcn_s_waitcnt(0);
        unsigned nloc = b.st[0], nx = b.st[1];
        if (nloc == 0u) { xcd_barrier_complete(bar, b.x, nloc, nx); b.st[0] = nloc; b.st[1] = nx; }
        const unsigned old = xb_add(&bar[XB_XSUB(b.x)], 1u);
        const unsigned gen = old / nloc;
        if (old + 1u == (gen + 1u) * nloc) {
            __builtin_amdgcn_fence(__ATOMIC_RELEASE, "agent");
            asm volatile("s_waitcnt vmcnt(0)" ::: "memory");
            const unsigned og = xb_add(&bar[XB_TOP], 1u);
            const unsigned tg = og / nx;
            if (og + 1u == (tg + 1u) * nx) xb_add(&bar[XB_TOPGEN], 1u);
            else XB_SPIN(xb_ld(&bar[XB_TOPGEN]) == tg, bar);
            __builtin_amdgcn_fence(__ATOMIC_ACQUIRE, "agent");
            xb_add(&bar[XB_XGEN(b.x)], 1u);
            asm volatile("s_waitcnt vmcnt(0)" ::: "memory");
        } else {
            XB_SPIN(xb_ld(&bar[XB_XGEN(b.x)]) == gen, bar);
            __builtin_amdgcn_fence(__ATOMIC_ACQUIRE, "agent");
            asm volatile("s_waitcnt vmcnt(0)" ::: "memory");
        }
    }
    __syncthreads();
}


__global__ void __launch_bounds__(NTHREADS, 1) mega_fwd(Params p_unused, int ph_lo, int ph_hi) {
    extern __shared__ __attribute__((aligned(16))) unsigned char smem[];
    __shared__ uint4 xb_words;
    if (threadIdx.x == 0) xb_words = make_uint4(0u, 0u, 0u, 0u);
    __syncthreads();
    const XcdBarrier xb = xcd_barrier_post((unsigned*)(((PP)__builtin_amdgcn_kernarg_segment_ptr())->ws + WS_BAR), (volatile LAS unsigned*)&xb_words);
    unsigned char* const smem_h = smem + half_id() * 65536;
    for (int ph = ph_lo; ph < ph_hi; ++ph) {
        PP p = (PP)__builtin_amdgcn_kernarg_segment_ptr();
        asm volatile("" : "+s"(p));
        for (int rep = 0; rep < (((PROBE_MASK >> ph) & 1) ? 2 : 1); ++rep) {
            if (rep) xcd_barrier(xb);
            if (ph == 0) prep_phase(p, smem_h);
            else if (ph == 1) prenorm_phase(p);
            else {
                const int l = (ph - 2) / 5, s = (ph - 2) % 5;
                if (s == 0 || s == 3) {
                    const bool inp = (s == 0);
                    gemm_phase((const u16*)(p->ws + (inp ? WS_H : WS_MIX)), inp ? (const u16*)(p->ws + WS_WIN) + (size_t)l * NINP * DM : (const u16*)(p->ws + WS_WOUT) + (size_t)l * DM * DM,
                               inp ? 12 : 4, (u16*)(p->ws + WS_Z), inp ? NIN : DM, inp ? 2 : 0, smem);
                }
                else if (s == 1) post_phase(p, l, smem_h);
                else if (s == 2) mix_phase(p, l, 2 * rep + l, smem);
                else final_phase(p, l);
            }
        }
        if (ph + 1 < ph_hi) { if (ph_hi == 0x7fffffff) cg::this_grid().sync(); else xcd_barrier(xb); }
    }
}

extern "C" void kernel_launch(void* const* d_in, const int* in_sizes, int n_in, void* d_out, int out_size, void* d_ws, size_t ws_size, hipStream_t stream) {
    static int grid = 0;
    if (grid == 0) {
        if (n_in != 28 || ws_size < WS_END) { fprintf(stderr, "kernel_launch: unexpected n_in %d / ws_size %zu (need %zu)\n", n_in, ws_size, (size_t)WS_END); grid = -1; return; }
        int dev = 0, cus = 0, per_cu = 0;
        (void)hipGetDevice(&dev);
        (void)hipDeviceGetAttribute(&cus, hipDeviceAttributeMultiprocessorCount, dev);
        if (hipFuncSetAttribute((const void*)mega_fwd, hipFuncAttributeMaxDynamicSharedMemorySize, 131072) != hipSuccess) fprintf(stderr, "kernel_launch: hipFuncSetAttribute failed\n");
        if (hipOccupancyMaxActiveBlocksPerMultiprocessor(&per_cu, (const void*)mega_fwd, NTHREADS, 131072) != hipSuccess || per_cu < 1) { fprintf(stderr, "kernel_launch: occupancy query failed (%d)\n", per_cu); per_cu = 1; }
        if (per_cu > 1) per_cu = 1;
        grid = cus * per_cu;
        fprintf(stderr, "kernel_launch: cus %d per_cu %d grid %d\n", cus, per_cu, grid);
    }
    if (grid < 0) return;
    (void)hipMemsetAsync((unsigned char*)d_ws + WS_BAR, 0, 3456 * 4, stream);
    Params p{};
    for (int i = 0; i < 28; ++i) p.in[i] = (const float*)d_in[i];
    p.out = (float*)d_out; p.ws = (unsigned char*)d_ws;
#if N_LAUNCH_SPLIT
    for (int ph = 0; ph < 12; ++ph) hipLaunchKernelGGL(mega_fwd, dim3(grid), dim3(NTHREADS), 131072, stream, p, ph, ph + 1);
#else
    int lo = 0, hi = 12;
    void* args[] = {&p, &lo, &hi};
    hipError_t e = hipLaunchCooperativeKernel((const void*)mega_fwd, dim3(grid), dim3(NTHREADS), args, 131072, stream);
    if (e != hipSuccess) fprintf(stderr, "cooperative launch failed: %s (grid %d)\n", hipGetErrorString(e), grid);
#endif
}
```

```cpp
#include <hip/hip_runtime.h>
#include <hip/hip_cooperative_groups.h>
#include <cstdio>
#include <cstdint>
namespace cg = cooperative_groups;

typedef unsigned short u16;
typedef short bf16x8 __attribute__((ext_vector_type(8)));
typedef float f32x4 __attribute__((ext_vector_type(4)));
typedef unsigned u32x4 __attribute__((ext_vector_type(4)));
typedef unsigned u32x2 __attribute__((ext_vector_type(2)));

#ifndef PROBE_MASK
#define PROBE_MASK 0
#endif
#ifndef PROBE_DUP
#define PROBE_DUP 0
#endif
#define N_LAUNCH_SPLIT 0

constexpr int NTOK = 16384, DM = 1024, NIN = 3104, NINP = 3200;
constexpr int NTHREADS = 512;
constexpr int VT = 256;
constexpr float EPS = 1e-6f;

constexpr size_t WS_WIN  = 0;
constexpr size_t WS_WOUT = WS_WIN  + (size_t)2 * NINP * DM * 2;
constexpr size_t WS_MOD  = WS_WOUT + (size_t)2 * DM * DM * 2;
constexpr size_t WS_ROPE = WS_MOD  + (size_t)2 * 9 * 3072 * 4;
constexpr size_t WS_CTR  = WS_ROPE + 64 * 16 * 8;
constexpr size_t WS_H    = WS_CTR  + 256;
constexpr size_t WS_Z    = WS_H    + (size_t)NTOK * DM * 2;
constexpr size_t WS_MIX  = WS_Z    + (size_t)NTOK * NIN * 2;
constexpr size_t WS_KA   = WS_MIX  + (size_t)NTOK * DM * 2;
constexpr size_t KA_ELEMS = (size_t)(32 * 2 * 256 + 8 * 2 * 1280) * 64;
constexpr size_t KB_ELEMS = (size_t)(32 * 4 * 256 + 8 * 4 * 1280) * 64;
constexpr size_t CV_ELEMS = (size_t)(32 * 4 * 256 + 8 * 4 * 1024) * 64;
constexpr size_t WS_VAT  = WS_KA  + KA_ELEMS * 2;
constexpr size_t WS_KB   = WS_VAT + KA_ELEMS * 2;
constexpr size_t WS_VBT  = WS_KB  + KB_ELEMS * 2;
constexpr size_t WS_CVT  = WS_VBT + KB_ELEMS * 2;
constexpr size_t WS_OC   = WS_CVT + CV_ELEMS * 2;
constexpr size_t WS_G    = WS_OC  + (size_t)NTOK * 256 * 4;
constexpr size_t WS_BAR  = WS_G   + (size_t)NTOK * 256 * 4;
constexpr size_t WS_END  = WS_BAR + 3456 * 4;

constexpr size_t OUT_Y   = 0;
constexpr size_t OUT_AK  = 16777216;
constexpr size_t OUT_AV  = OUT_AK + 2097152;
constexpr size_t OUT_BK  = OUT_AV + 2097152;
constexpr size_t OUT_BV  = OUT_BK + 4194304;
constexpr size_t OUT_SF  = OUT_BV + 4194304;
constexpr size_t OUT_SB  = OUT_SF + 524288;

struct Params {
    const float* in[28];
    float* out;
    unsigned char* ws;
};
typedef const __attribute__((address_space(4))) Params* PP;
enum { I_XP = 0, I_XS, I_C, I_CAK, I_CAV, I_CBK, I_CBV, I_SCF, I_SCB, I_CCTX, I_WMOD, I_BMOD, I_GPRE, I_GPOST, I_WIN, I_WOUT,
       I_AQG, I_AKG, I_LQ1, I_LK1, I_LQ2, I_LK2, I_BOG, I_CWF, I_CBF, I_CWB, I_CBB, I_COG };

__device__ __forceinline__ int opaque_tid() { int t = threadIdx.x; asm volatile("" : "+v"(t)); return t; }
__device__ __forceinline__ int vtid() { return opaque_tid() & 255; }
__device__ __forceinline__ int half_id() { return __builtin_amdgcn_readfirstlane(threadIdx.x >> 8); }
typedef __bf16 bf16x2_t __attribute__((ext_vector_type(2)));
typedef float f32x2_t __attribute__((ext_vector_type(2)));
__device__ __forceinline__ unsigned pk2(float lo, float hi) { const f32x2_t v = {lo, hi}; return __builtin_bit_cast(unsigned, __builtin_convertvector(v, bf16x2_t)); }
__device__ __forceinline__ float bflo(unsigned w) { return __uint_as_float(w << 16); }
__device__ __forceinline__ float bfhi(unsigned w) { return __uint_as_float(w & 0xffff0000u); }
__device__ __forceinline__ float fast_exp2(float x) { return __builtin_amdgcn_exp2f(x); }
__device__ __forceinline__ float silu_f(float v) { return v * __builtin_amdgcn_rcpf(1.f + __expf(-v)); }
template <int CTRL> __device__ __forceinline__ float dppf(float v) { return __int_as_float(__builtin_amdgcn_mov_dpp(__float_as_int(v), CTRL, 0xf, 0xf, true)); }
__device__ __forceinline__ float xor1f(float v) { return dppf<0xB1>(v); }
__device__ __forceinline__ float xor2f(float v) { return dppf<0x4E>(v); }
__device__ __forceinline__ float sum8(float v) { v += xor1f(v); v += xor2f(v); v += dppf<0x141>(v); return v; }
__device__ __forceinline__ float sum16(float v) { v = sum8(v); v += dppf<0x140>(v); return v; }
__device__ __forceinline__ float rows_sum(float v) {
    unsigned u = __float_as_uint(v);
    auto r = __builtin_amdgcn_permlane16_swap(u, u, false, false);
    v = __uint_as_float(r[0]) + __uint_as_float(r[1]);
    u = __float_as_uint(v);
    auto r2 = __builtin_amdgcn_permlane32_swap(u, u, false, false);
    return __uint_as_float(r2[0]) + __uint_as_float(r2[1]);
}
__device__ __forceinline__ float wave_sum(float v) { return rows_sum(sum16(v)); }
__device__ __forceinline__ f32x4 mfma16(bf16x8 a, bf16x8 b, f32x4 c) { return __builtin_amdgcn_mfma_f32_16x16x32_bf16(a, b, c, 0, 0, 0); }
__device__ __forceinline__ bf16x8 as_bf8(u32x4 v) { return __builtin_bit_cast(bf16x8, v); }
__device__ __forceinline__ int swz(int row, int chunk) { return row * 128 + ((chunk ^ ((row >> 1) & 7)) << 4); }
__device__ __forceinline__ size_t kv_off(int grp, int b, int h, int H, int LS) {
    return grp ? ((size_t)32 * H * 256 + (size_t)(b * H + h) * LS) * 64 : (size_t)(b * H + h) * 256 * 64;
}

__device__ void prep_phase(PP p, unsigned char* smem) {
    const int tid = vtid(), lane = tid & 63, w = __builtin_amdgcn_readfirstlane(tid >> 6), hb = half_id();
    constexpr int NMOD = 192, NT_IN = 16 * 50, NT_OUT = 16 * 16;
    constexpr int NITEMS = NMOD + 2 * (NT_IN + NT_OUT) + 1;
    float* MODW = (float*)(p->ws + WS_MOD);
    for (int it0 = blockIdx.x * 2; it0 < NITEMS + 1; it0 += gridDim.x * 2) {
        const int it = it0 + hb;
        asm volatile("" : "+s"(p));
        if (it < NMOD) {
            const int l = it / 96, cgp = it % 96;
            float* red = (float*)smem;
            const int cq = tid & 7, kg = tid >> 3;
            const float* wp = p->in[I_WMOD] + (size_t)l * 1024 * 3072 + cgp * 32 + cq * 4;
            const float* cc = p->in[I_C]; const float* cx = p->in[I_CCTX];
            float acc[9][4];
#pragma unroll
            for (int r = 0; r < 9; ++r) { acc[r][0] = 0.f; acc[r][1] = 0.f; acc[r][2] = 0.f; acc[r][3] = 0.f; }
#pragma unroll 4
            for (int kk = 0; kk < 32; ++kk) {
                const int k = kg * 32 + kk;
                const float4 w4 = *(const float4*)(wp + (size_t)k * 3072);
                float cv[9];
                cv[0] = cx[k];
#pragma unroll
                for (int r = 1; r < 9; ++r) cv[r] = cc[(r - 1) * 1024 + k];
#pragma unroll
                for (int r = 0; r < 9; ++r) { const float s = cv[r] * __builtin_amdgcn_rcpf(1.f + __expf(-cv[r])); acc[r][0] += s * w4.x; acc[r][1] += s * w4.y; acc[r][2] += s * w4.z; acc[r][3] += s * w4.w; }
            }
#pragma unroll
            for (int r = 0; r < 9; ++r)
#pragma unroll
                for (int j = 0; j < 4; ++j) { float v = acc[r][j]; v += dppf<0x128>(v); v = rows_sum(v); acc[r][j] = v; }
            if ((lane >> 3) == 0) {
#pragma unroll
                for (int r = 0; r < 9; ++r)
#pragma unroll
                    for (int j = 0; j < 4; ++j) red[(w * 9 + r) * 32 + cq * 4 + j] = acc[r][j];
            }
            __syncthreads();
            for (int i = tid; i < 288; i += VT) {
                const int r = i >> 5, c = i & 31;
                const float v = red[(0 * 9 + r) * 32 + c] + red[(1 * 9 + r) * 32 + c] + red[(2 * 9 + r) * 32 + c] + red[(3 * 9 + r) * 32 + c] + p->in[I_BMOD][l * 3072 + cgp * 32 + c];
                MODW[(size_t)(l * 9 + r) * 3072 + cgp * 32 + c] = v;
            }
        } else if (it < NITEMS - 1) {
            int r = it - NMOD;
            const float* src; u16* dst; int N, NT;
            if (r < 2 * NT_IN) { const int l = r / NT_IN; r %= NT_IN; src = p->in[I_WIN] + (size_t)l * 1024 * NIN; dst = (u16*)(p->ws + WS_WIN) + (size_t)l * NINP * DM; N = NIN; NT = 50; }
            else { r -= 2 * NT_IN; const int l = r / NT_OUT; r %= NT_OUT; src = p->in[I_WOUT] + (size_t)l * 1024 * 1024; dst = (u16*)(p->ws + WS_WOUT) + (size_t)l * DM * DM; N = 1024; NT = 16; }
            const int kt = r / NT, nt = r % NT, k0 = kt * 64, n0 = nt * 64;
            float* T = (float*)smem;
#pragma unroll
            for (int i = 0; i < 4; ++i) {
                const int rr = (tid >> 4) + 16 * i, c = (tid & 15) * 4;
                float4 v = make_float4(0.f, 0.f, 0.f, 0.f);
                if (n0 + c < N) v = *(const float4*)(src + (size_t)(k0 + rr) * N + n0 + c);
                T[rr * 65 + c] = v.x; T[rr * 65 + c + 1] = v.y; T[rr * 65 + c + 2] = v.z; T[rr * 65 + c + 3] = v.w;
            }
            __syncthreads();
            const int n = tid >> 2, kq = tid & 3;
            u32x4 o0, o1;
            o0.x = pk2(T[(kq * 16 + 0) * 65 + n], T[(kq * 16 + 1) * 65 + n]);   o0.y = pk2(T[(kq * 16 + 2) * 65 + n], T[(kq * 16 + 3) * 65 + n]);
            o0.z = pk2(T[(kq * 16 + 4) * 65 + n], T[(kq * 16 + 5) * 65 + n]);   o0.w = pk2(T[(kq * 16 + 6) * 65 + n], T[(kq * 16 + 7) * 65 + n]);
            o1.x = pk2(T[(kq * 16 + 8) * 65 + n], T[(kq * 16 + 9) * 65 + n]);   o1.y = pk2(T[(kq * 16 + 10) * 65 + n], T[(kq * 16 + 11) * 65 + n]);
            o1.z = pk2(T[(kq * 16 + 12) * 65 + n], T[(kq * 16 + 13) * 65 + n]); o1.w = pk2(T[(kq * 16 + 14) * 65 + n], T[(kq * 16 + 15) * 65 + n]);
            u16* d = dst + (size_t)(n0 + n) * DM + k0 + kq * 16;
            *(u32x4*)d = o0; *(u32x4*)(d + 8) = o1;
        } else {
            float2* tab = (float2*)(p->ws + WS_ROPE);
            for (int i = tid; i < (it == NITEMS - 1 ? 1024 : 0); i += VT) {
                const int pos = i >> 4, fi = i & 15;
                const float freq = powf(10000.f, -(float)fi / 16.f);
                const float ang = (float)pos * freq;
                float s, c; sincosf(ang, &s, &c);
                tab[i] = make_float2(c, s);
            }
            if (it == NITEMS - 1 && tid < 8) ((unsigned*)(p->ws + WS_CTR))[tid] = 0u;
        }
        __syncthreads();
    }
}

__device__ __forceinline__ void prenorm_phase(PP p) {
    const int tid = opaque_tid(), lane = tid & 63, w = __builtin_amdgcn_readfirstlane(tid >> 6);
    const float* MODW = (const float*)(p->ws + WS_MOD);
    u16* H = (u16*)(p->ws + WS_H);
#pragma unroll 2
    for (int row = blockIdx.x * 8 + w; row < NTOK; row += gridDim.x * 8) {
        const float* xr = row < 8192 ? p->in[I_XP] + (size_t)row * DM : p->in[I_XS] + (size_t)(row - 8192) * DM;
        const int mrow = row < 8192 ? 0 : 1 + ((row - 8192) >> 10);
        const float* md = MODW + (size_t)mrow * 3072;
        float4 v[4]; float ss = 0.f;
#pragma unroll
        for (int j = 0; j < 4; ++j) { v[j] = *(const float4*)(xr + lane * 4 + 256 * j); ss += v[j].x * v[j].x + v[j].y * v[j].y + v[j].z * v[j].z + v[j].w * v[j].w; }
        const float rstd = rsqrtf(wave_sum(ss) * (1.f / DM) + EPS);
#pragma unroll
        for (int j = 0; j < 4; ++j) {
            const int c = lane * 4 + 256 * j;
            const float4 g = *(const float4*)(p->in[I_GPRE] + c), sh = *(const float4*)(md + c), scl = *(const float4*)(md + 1024 + c);
            u32x2 o;
            o.x = pk2(v[j].x * rstd * g.x * (1.f + scl.x) + sh.x, v[j].y * rstd * g.y * (1.f + scl.y) + sh.y);
            o.y = pk2(v[j].z * rstd * g.z * (1.f + scl.z) + sh.z, v[j].w * rstd * g.w * (1.f + scl.w) + sh.w);
            *(u32x2*)(H + (size_t)row * DM + c) = o;
        }
    }
}

__device__ __forceinline__ void final_phase(PP p, int l) {
    const int tid = opaque_tid(), lane = tid & 63, w = __builtin_amdgcn_readfirstlane(tid >> 6);
    const float* MODW = (const float*)(p->ws + WS_MOD);
    const u16* Y = (const u16*)(p->ws + WS_Z);
    u16* H = (u16*)(p->ws + WS_H);
#pragma unroll 2
    for (int row = blockIdx.x * 8 + w; row < NTOK; row += gridDim.x * 8) {
        const float* xr = (l == 0) ? (row < 8192 ? p->in[I_XP] + (size_t)row * DM : p->in[I_XS] + (size_t)(row - 8192) * DM) : p->out + OUT_Y + (size_t)row * DM;
        const int mrow = row < 8192 ? 0 : 1 + ((row - 8192) >> 10);
        const float* md = MODW + (size_t)(l * 9 + mrow) * 3072;
        float4 y[4], x[4]; float ss = 0.f;
#pragma unroll
        for (int j = 0; j < 4; ++j) {
            { const u32x2 yr = *(const u32x2*)(Y + (size_t)row * DM + lane * 4 + 256 * j); y[j] = make_float4(bflo(yr.x), bfhi(yr.x), bflo(yr.y), bfhi(yr.y)); }
            x[j] = *(const float4*)(xr + lane * 4 + 256 * j);
            ss += y[j].x * y[j].x + y[j].y * y[j].y + y[j].z * y[j].z + y[j].w * y[j].w;
        }
        const float rstd = rsqrtf(wave_sum(ss) * (1.f / DM) + EPS);
        float ss2 = 0.f;
#pragma unroll
        for (int j = 0; j < 4; ++j) {
            const int c = lane * 4 + 256 * j;
            const float4 g = *(const float4*)(p->in[I_GPOST] + l * DM + c), gt = *(const float4*)(md + 2048 + c);
            x[j].x += gt.x * (y[j].x * rstd * g.x); x[j].y += gt.y * (y[j].y * rstd * g.y); x[j].z += gt.z * (y[j].z * rstd * g.z); x[j].w += gt.w * (y[j].w * rstd * g.w);
            *(float4*)(p->out + OUT_Y + (size_t)row * DM + c) = x[j];
            ss2 += x[j].x * x[j].x + x[j].y * x[j].y + x[j].z * x[j].z + x[j].w * x[j].w;
        }
        if (l == 0) {
            const float rstd2 = rsqrtf(wave_sum(ss2) * (1.f / DM) + EPS);
            const float* md1 = MODW + (size_t)(9 + mrow) * 3072;
#pragma unroll
            for (int j = 0; j < 4; ++j) {
                const int c = lane * 4 + 256 * j;
                const float4 g = *(const float4*)(p->in[I_GPRE] + DM + c), sh = *(const float4*)(md1 + c), scl = *(const float4*)(md1 + 1024 + c);
                u32x2 o;
                o.x = pk2(x[j].x * rstd2 * g.x * (1.f + scl.x) + sh.x, x[j].y * rstd2 * g.y * (1.f + scl.y) + sh.y);
                o.y = pk2(x[j].z * rstd2 * g.z * (1.f + scl.z) + sh.z, x[j].w * rstd2 * g.w * (1.f + scl.w) + sh.w);
                *(u32x2*)(H + (size_t)row * DM + c) = o;
            }
        }
    }
}

typedef __attribute__((address_space(3))) unsigned* lds_u32p;
__device__ __forceinline__ void dma16(const void* g, void* l) { __builtin_amdgcn_global_load_lds((const unsigned*)g, (lds_u32p)l, 16, 0, 0); }

__device__ __forceinline__ void gemm_phase(const u16* __restrict__ A, const u16* __restrict__ BT, int ntn, u16* __restrict__ C, int ldc, int tail16, unsigned char* smem) {
    const int tid = opaque_tid(), lane = tid & 63, w = __builtin_amdgcn_readfirstlane(tid >> 6), wm = w >> 2, wn = w & 3, fr = lane & 15, quad = lane >> 4;
    const int lrow = tid >> 3, lch = tid & 7, gch = lch ^ ((lrow >> 1) & 7);
    unsigned char* As = smem;
    unsigned char* Bs = smem + 65536;
    const int xcd = blockIdx.x & 7, jloc = blockIdx.x >> 3, nloc = gridDim.x >> 3, per_x = 8 * ntn;
    for (int tl = jloc; tl < per_x; tl += nloc) {
        const int mt_ = xcd * 8 + (tl & 7), nt_ = tl >> 3, m0 = mt_ * 256, n0 = nt_ * 256;
        const u16* gA = A + (size_t)(m0 + lrow) * DM + gch * 8;
        const u16* gB = BT + (size_t)(n0 + lrow) * DM + gch * 8;
        f32x4 acc[8][4];
#pragma unroll
        for (int i = 0; i < 8; ++i)
#pragma unroll
            for (int j = 0; j < 4; ++j) acc[i][j] = (f32x4){0.f, 0.f, 0.f, 0.f};
#pragma unroll
        for (int i = 0; i < 4; ++i) { dma16(gA + (size_t)i * 64 * DM, As + i * 8192 + tid * 16); dma16(gB + (size_t)i * 64 * DM, Bs + i * 8192 + tid * 16); }
        __syncthreads();
        for (int kt = 0; kt < 16; ++kt) {
            const int buf = kt & 1;
            if (kt < 15) {
#pragma unroll
                for (int i = 0; i < 4; ++i) {
                    dma16(gA + (size_t)i * 64 * DM + (kt + 1) * 64, As + (buf ^ 1) * 32768 + i * 8192 + tid * 16);
                    dma16(gB + (size_t)i * 64 * DM + (kt + 1) * 64, Bs + (buf ^ 1) * 32768 + i * 8192 + tid * 16);
                }
            }
            const unsigned char* Ab = As + buf * 32768; const unsigned char* Bb = Bs + buf * 32768;
#pragma unroll
            for (int ks = 0; ks < 2; ++ks) {
                bf16x8 bfr[4];
#pragma unroll
                for (int j = 0; j < 4; ++j) bfr[j] = *(const bf16x8*)(Bb + swz(wn * 64 + j * 16 + fr, ks * 4 + quad));
#pragma unroll
                for (int ih = 0; ih < 2; ++ih) {
                    bf16x8 af[4];
#pragma unroll
                    for (int i = 0; i < 4; ++i) af[i] = *(const bf16x8*)(Ab + swz(wm * 128 + (ih * 4 + i) * 16 + fr, ks * 4 + quad));
#pragma unroll
                    for (int i = 0; i < 4; ++i)
#pragma unroll
                        for (int j = 0; j < 4; ++j) acc[ih * 4 + i][j] = mfma16(bfr[j], af[i], acc[ih * 4 + i][j]);
                }
            }
            __syncthreads();
        }
#pragma unroll
        for (int i = 0; i < 8; ++i)
#pragma unroll
            for (int jp = 0; jp < 2; ++jp) {
                const unsigned ax = pk2(acc[i][2 * jp][0], acc[i][2 * jp][1]), ay = pk2(acc[i][2 * jp][2], acc[i][2 * jp][3]);
                const unsigned bx = pk2(acc[i][2 * jp + 1][0], acc[i][2 * jp + 1][1]), by = pk2(acc[i][2 * jp + 1][2], acc[i][2 * jp + 1][3]);
                const auto sx = __builtin_amdgcn_permlane16_swap(ax, bx, false, false);
                const auto sy = __builtin_amdgcn_permlane16_swap(ay, by, false, false);
                const int row = m0 + wm * 128 + i * 16 + fr;
                const int col = n0 + wn * 64 + ((quad & 1) ? (2 * jp + 1) * 16 + (quad - 1) * 4 : (2 * jp) * 16 + quad * 4);
                *(u32x4*)(C + (size_t)row * ldc + col) = (u32x4){sx[0], sy[0], sx[1], sy[1]};
            }
    }
    if (tail16 > 0) {
        const int ntask = 1024 * tail16;
        for (int task = blockIdx.x * 8 + w; task < ntask; task += gridDim.x * 8) {
            const int mt16 = task / tail16, nt16 = task % tail16, col0 = ntn * 256 + nt16 * 16;
            const u16* ap = A + (size_t)(mt16 * 16 + fr) * DM + quad * 8;
            const u16* bp = BT + (size_t)(col0 + fr) * DM + quad * 8;
            f32x4 acc = (f32x4){0.f, 0.f, 0.f, 0.f};
#pragma unroll 8
            for (int ks = 0; ks < 32; ++ks) acc = mfma16(*(const bf16x8*)(bp + ks * 32), *(const bf16x8*)(ap + ks * 32), acc);
            u32x2 o; o.x = pk2(acc[0], acc[1]); o.y = pk2(acc[2], acc[3]);
            *(u32x2*)(C + (size_t)(mt16 * 16 + fr) * ldc + col0 + quad * 4) = o;
        }
    }
}

__device__ __forceinline__ float log_sigmoid_f(float x) { return fminf(x, 0.f) - __logf(1.f + __expf(-fabsf(x))); }
__device__ __forceinline__ void unpack8(u32x4 r, float (&v)[8]) {
    v[0] = bflo(r.x); v[1] = bfhi(r.x); v[2] = bflo(r.y); v[3] = bfhi(r.y); v[4] = bflo(r.z); v[5] = bfhi(r.z); v[6] = bflo(r.w); v[7] = bfhi(r.w);
}
__device__ __forceinline__ u32x4 pack8(const float (&v)[8]) { u32x4 o; o.x = pk2(v[0], v[1]); o.y = pk2(v[2], v[3]); o.z = pk2(v[4], v[5]); o.w = pk2(v[6], v[7]); return o; }
__device__ __forceinline__ void store8f(float* d, const float (&v)[8]) { *(float4*)d = make_float4(v[0], v[1], v[2], v[3]); *(float4*)(d + 4) = make_float4(v[4], v[5], v[6], v[7]); }
__device__ __forceinline__ void vt_store(u16* Tl, u32x4 raw, int tok_l, int sub, u16* vt_base, int rowlen, int tcol0) {
    const int tid = vtid();
    const int tc = tok_l ^ (sub * 4);
    Tl[(sub * 8 + 0) * 40 + tc] = (u16)(raw.x & 0xffff); Tl[(sub * 8 + 1) * 40 + tc] = (u16)(raw.x >> 16);
    Tl[(sub * 8 + 2) * 40 + tc] = (u16)(raw.y & 0xffff); Tl[(sub * 8 + 3) * 40 + tc] = (u16)(raw.y >> 16);
    Tl[(sub * 8 + 4) * 40 + tc] = (u16)(raw.z & 0xffff); Tl[(sub * 8 + 5) * 40 + tc] = (u16)(raw.z >> 16);
    Tl[(sub * 8 + 6) * 40 + tc] = (u16)(raw.w & 0xffff); Tl[(sub * 8 + 7) * 40 + tc] = (u16)(raw.w >> 16);
    __syncthreads();
    const int d = tid >> 2, part = tid & 3;
    const int sx = (d >> 3) * 4;
    const u32x2 pa = *(const u32x2*)(Tl + d * 40 + ((part * 4) ^ sx)), pb = *(const u32x2*)(Tl + d * 40 + ((16 + part * 4) ^ sx));
    *(u32x4*)(vt_base + (size_t)d * rowlen + tcol0 + part * 8) = (u32x4){pa.x, pa.y, pb.x, pb.y};
    __syncthreads();
}

__device__ void post_phase(PP p, int l, unsigned char* smem) {
    const int tid = vtid(), tok_l = tid >> 3, sub = tid & 7, hb = half_id();
    u16* Tl = (u16*)smem;
    u16* Z = (u16*)(p->ws + WS_Z);
    u16* KA = (u16*)(p->ws + WS_KA); u16* VAT = (u16*)(p->ws + WS_VAT);
    u16* KB = (u16*)(p->ws + WS_KB); u16* VBT = (u16*)(p->ws + WS_VBT); u16* CVT = (u16*)(p->ws + WS_CVT);
    const float2* tab = (const float2*)(smem + 8192);
    const float* gwL = (const float*)(smem + 16384);
    const float* gbL = (const float*)(smem + 32768);
    {
        const float2* tabg = (const float2*)(p->ws + WS_ROPE);
        for (int i = tid; i < 1024; i += VT) ((float2*)(smem + 8192))[i] = tabg[i];
        for (int i = tid; i < 4096; i += VT) ((float*)(smem + 16384))[i] = ((i >> 11) ? p->in[I_CWB] : p->in[I_CWF])[l * 2048 + (i & 2047)];
        if (tid < 256) ((float*)(smem + 32768))[tid] = ((tid >> 7) ? p->in[I_CBB] : p->in[I_CBF])[l * 128 + (tid & 127)];
    }
    float gq[8], gk[8];
#pragma unroll
    for (int i = 0; i < 8; ++i) { gq[i] = p->in[I_AQG][l * 64 + sub * 8 + i]; gk[i] = p->in[I_AKG][l * 64 + sub * 8 + i]; }
    __syncthreads();
    for (int it0 = blockIdx.x * 2; it0 < 512 + 768; it0 += gridDim.x * 2) {
        const int it = it0 + hb;
        asm volatile("" : "+s"(p));
        if (it < 512) {
            const int tok0 = it * 32, grp = tok0 >= 8192;
            const int b = grp ? (tok0 - 8192) >> 10 : tok0 >> 8, t0 = grp ? (tok0 - 8192) & 1023 : tok0 & 255;
            const int tok = tok0 + tok_l, t = t0 + tok_l;
            const int Lk = grp ? 1280 : 256, kof = grp ? 256 : 0;
            const int prow = t >> 6, pcol = t & 63;
            u32x4 raw_next = *(const u32x4*)(Z + (size_t)tok * NIN + sub * 8);
            for (int u = 0; u < 28; ++u) {
                const int col0 = u < 24 ? u * 64 : 1792 + (u - 24) * 64;
                u16* zp = Z + (size_t)tok * NIN + col0 + sub * 8;
                u32x4 raw = raw_next;
                if (u + 1 < 28) { const int coln = (u + 1) < 24 ? (u + 1) * 64 : 1792 + (u + 1 - 24) * 64; raw_next = *(const u32x4*)(Z + (size_t)tok * NIN + coln + sub * 8); }
                if (u < 10) {
                    float v[8]; unpack8(raw, v);
                    float ss = 0.f;
#pragma unroll
                    for (int i = 0; i < 8; ++i) ss += v[i] * v[i];
                    ss = sum8(ss);
                    const float rstd = rsqrtf(ss * (1.f / 64.f) + EPS);
#pragma unroll
                    for (int i = 0; i < 8; ++i) v[i] = v[i] * rstd * (u < 8 ? gq[i] : gk[i]);
                    if (u >= 8 && !grp) store8f(p->out + OUT_AK + ((size_t)((b * 2 + l) * 2 + (u - 8)) * 256 + t) * 64 + sub * 8, v);
                    if (grp) {
                        const int pos = (sub & 4) ? pcol : prow;
#pragma unroll
                        for (int i = 0; i < 8; ++i) {
                            const float pr = xor2f(v[i]);
                            const float2 cs = tab[pos * 16 + (sub & 1) * 8 + i];
                            v[i] = (sub & 2) ? v[i] * cs.x + pr * cs.y : v[i] * cs.x - pr * cs.y;
                        }
                    }
                    const u32x4 o = pack8(v);
                    if (u < 8) *(u32x4*)zp = o;
                    else *(u32x4*)(KA + kv_off(grp, b, u - 8, 2, 1280) + (size_t)(kof + t) * 64 + sub * 8) = o;
                } else if (u < 12) {
                    const int kvh = u - 10;
                    if (!grp) { float v[8]; unpack8(raw, v); store8f(p->out + OUT_AV + ((size_t)((b * 2 + l) * 2 + kvh) * 256 + t) * 64 + sub * 8, v); }
                    vt_store(Tl, raw, tok_l, sub, VAT + kv_off(grp, b, kvh, 2, 1280), Lk, kof + t0);
                } else if (u < 20) {
                    const int isk = u >= 16, h = isk ? u - 16 : u - 12;
                    float v[8]; unpack8(raw, v);
                    if (isk && !grp) store8f(p->out + OUT_BK + ((size_t)((b * 2 + l) * 4 + h) * 256 + t) * 64 + sub * 8, v);
                    if (grp) {
                        const int pos = (sub & 2) ? pcol : prow;
#pragma unroll
                        for (int i = 0; i < 8; ++i) {
                            const float pr = xor1f(v[i]);
                            const float2 cs = tab[pos * 16 + 2 * i];
                            v[i] = (sub & 1) ? v[i] * cs.x + pr * cs.y : v[i] * cs.x - pr * cs.y;
                        }
                        raw = pack8(v);
                    }
                    if (!isk) { if (grp) *(u32x4*)zp = raw; }
                    else *(u32x4*)(KB + kv_off(grp, b, h, 4, 1280) + (size_t)(kof + t) * 64 + sub * 8) = raw;
                } else if (u < 24) {
                    const int h = u - 20;
                    if (!grp) { float v[8]; unpack8(raw, v); store8f(p->out + OUT_BV + ((size_t)((b * 2 + l) * 4 + h) * 256 + t) * 64 + sub * 8, v); }
                    vt_store(Tl, raw, tok_l, sub, VBT + kv_off(grp, b, h, 4, 1280), Lk, kof + t0);
                } else {
                    const int h = u - 24;
                    vt_store(Tl, raw, tok_l, sub, CVT + kv_off(grp, b, h, 4, 1024), grp ? 1024 : 256, t0);
                }
            }
            {
                const int dir = sub >> 2, c0 = (sub & 3) * 32;
                float lr[16];
                { float t8[8];
                  unpack8(*(const u32x4*)(Z + (size_t)tok * NIN + 2048 + dir * 16), t8);
#pragma unroll
                  for (int i = 0; i < 8; ++i) lr[i] = t8[i];
                  unpack8(*(const u32x4*)(Z + (size_t)tok * NIN + 2048 + dir * 16 + 8), t8);
#pragma unroll
                  for (int i = 0; i < 8; ++i) lr[8 + i] = t8[i]; }
                const float* gw = gwL + dir * 2048 + c0;
                const float* gb = gbL + dir * 128 + c0;
                float* gout = (float*)(p->ws + WS_G) + (size_t)tok * 256 + dir * 128 + c0;
#pragma unroll 1
                for (int cc = 0; cc < 8; ++cc) {
                    float4 a = *(const float4*)(gb + cc * 4);
#pragma unroll
                    for (int r = 0; r < 16; ++r) { const float4 w4 = *(const float4*)(gw + r * 128 + cc * 4); a.x += lr[r] * w4.x; a.y += lr[r] * w4.y; a.z += lr[r] * w4.z; a.w += lr[r] * w4.w; }
                    a.x = log_sigmoid_f(a.x) * (1.f / 16.f); a.y = log_sigmoid_f(a.y) * (1.f / 16.f); a.z = log_sigmoid_f(a.z) * (1.f / 16.f); a.w = log_sigmoid_f(a.w) * (1.f / 16.f);
                    *(float4*)(gout + cc * 4) = a;
                }
            }
        } else {
            const int idx = it - 512, cu = idx % 12, rest = idx / 12, ktile = rest & 7, b = rest >> 3;
            const int key0 = ktile * 32, key = key0 + tok_l;
            const float* src; int hh, H;
            if (cu < 2) { hh = cu; H = 2; src = p->in[I_CAK]; } else if (cu < 4) { hh = cu - 2; H = 2; src = p->in[I_CAV]; }
            else if (cu < 8) { hh = cu - 4; H = 4; src = p->in[I_CBK]; } else { hh = cu - 8; H = 4; src = p->in[I_CBV]; }
            const float* sp = src + ((size_t)((b * 2 + l) * H + hh) * 256 + key) * 64 + sub * 8;
            const float4 a0 = *(const float4*)sp, a1 = *(const float4*)(sp + 4);
            u32x4 o; o.x = pk2(a0.x, a0.y); o.y = pk2(a0.z, a0.w); o.z = pk2(a1.x, a1.y); o.w = pk2(a1.z, a1.w);
            if (cu < 2) *(u32x4*)(KA + kv_off(1, b, hh, 2, 1280) + (size_t)key * 64 + sub * 8) = o;
            else if (cu < 4) vt_store(Tl, o, tok_l, sub, VAT + kv_off(1, b, hh, 2, 1280), 1280, key0);
            else if (cu < 8) *(u32x4*)(KB + kv_off(1, b, hh, 4, 1280) + (size_t)key * 64 + sub * 8) = o;
            else vt_store(Tl, o, tok_l, sub, VBT + kv_off(1, b, hh, 4, 1280), 1280, key0);
        }
    }
}

__device__ __forceinline__ float quad_max(float v) {
    unsigned u = __float_as_uint(v);
    auto r = __builtin_amdgcn_permlane16_swap(u, u, false, false);
    v = fmaxf(__uint_as_float(r[0]), __uint_as_float(r[1]));
    u = __float_as_uint(v);
    auto r2 = __builtin_amdgcn_permlane32_swap(u, u, false, false);
    return fmaxf(__uint_as_float(r2[0]), __uint_as_float(r2[1]));
}

template <int NP>
__device__ __forceinline__ void attn_sweep(const u16* __restrict__ Kg, const u16* __restrict__ Vg, int Lk, const bf16x8 (&qf)[2][2], unsigned char* smem, f32x4 (&O)[NP][4][2]) {
    const int tid = vtid(), lane = tid & 63, fr = lane & 15, quad = lane >> 4;
    float mrun[NP][2]; f32x4 Lacc[NP][2];
#pragma unroll
    for (int pp = 0; pp < NP; ++pp)
#pragma unroll
        for (int qs = 0; qs < 2; ++qs) {
            mrun[pp][qs] = -INFINITY; Lacc[pp][qs] = (f32x4){0.f, 0.f, 0.f, 0.f};
#pragma unroll
            for (int dt = 0; dt < 4; ++dt) O[pp][dt][qs] = (f32x4){0.f, 0.f, 0.f, 0.f};
        }
    unsigned char* Ks = smem;
    unsigned char* Vs = smem + 16384;
    const int t512 = opaque_tid(), lrow = t512 >> 3, lch = t512 & 7;
    u32x4 rk, rv;
    rk = *(const u32x4*)(Kg + (size_t)lrow * 64 + lch * 8); rv = *(const u32x4*)(Vg + (size_t)lrow * Lk + lch * 8);
    *(u32x4*)(Ks + swz(lrow, lch)) = rk; *(u32x4*)(Vs + swz(lrow, lch)) = rv;
    __syncthreads();
    const int ntile = Lk >> 6;
    for (int t = 0; t < ntile; ++t) {
        const int buf = t & 1;
        if (t + 1 < ntile) {
            rk = *(const u32x4*)(Kg + (size_t)((t + 1) * 64 + lrow) * 64 + lch * 8);
            rv = *(const u32x4*)(Vg + (size_t)lrow * Lk + (t + 1) * 64 + lch * 8);
        }
        const unsigned char* Kb = Ks + buf * 8192; const unsigned char* Vb = Vs + buf * 8192;
#pragma unroll
        for (int pp = 0; pp < NP; ++pp) {
            f32x4 S[4][2];
#pragma unroll
            for (int kt = 0; kt < 4; ++kt) { S[kt][0] = (f32x4){0.f, 0.f, 0.f, 0.f}; S[kt][1] = (f32x4){0.f, 0.f, 0.f, 0.f}; }
#pragma unroll
            for (int kt = 0; kt < 4; ++kt)
#pragma unroll
                for (int ks = (NP == 2 ? pp : 0); ks < (NP == 2 ? pp + 1 : 2); ++ks) {
                    const bf16x8 kf = *(const bf16x8*)(Kb + swz(kt * 16 + fr, ks * 4 + quad));
                    S[kt][0] = mfma16(kf, qf[0][ks], S[kt][0]);
                    S[kt][1] = mfma16(kf, qf[1][ks], S[kt][1]);
                }
            bf16x8 pf[2][2];
#pragma unroll
            for (int qs = 0; qs < 2; ++qs) {
                float mx = -INFINITY;
#pragma unroll
                for (int kt = 0; kt < 4; ++kt)
#pragma unroll
                    for (int r = 0; r < 4; ++r) mx = fmaxf(mx, S[kt][qs][r]);
                mx = quad_max(mx);
                const float mold = mrun[pp][qs];
                const float mnew = fmaxf(mold, mx);
                mrun[pp][qs] = mnew;
                const f32x4 mv = (f32x4){mnew, mnew, mnew, mnew};
#pragma unroll
                for (int kt = 0; kt < 4; ++kt) {
                    const f32x4 d = S[kt][qs] - mv;
                    f32x4 e; e[0] = fast_exp2(d[0]); e[1] = fast_exp2(d[1]); e[2] = fast_exp2(d[2]); e[3] = fast_exp2(d[3]);
                    S[kt][qs] = e;
                }
                if (__builtin_amdgcn_ballot_w64(mnew != mold) != 0ull) {
                    const float alpha = fast_exp2(mold - mnew);
                    Lacc[pp][qs] *= alpha;
#pragma unroll
                    for (int dt = 0; dt < 4; ++dt) O[pp][dt][qs] *= alpha;
                }
#pragma unroll
                for (int kb = 0; kb < 2; ++kb) {
                    u32x4 pk; pk.x = pk2(S[2 * kb][qs][0], S[2 * kb][qs][1]); pk.y = pk2(S[2 * kb][qs][2], S[2 * kb][qs][3]);
                    pk.z = pk2(S[2 * kb + 1][qs][0], S[2 * kb + 1][qs][1]); pk.w = pk2(S[2 * kb + 1][qs][2], S[2 * kb + 1][qs][3]);
                    pf[qs][kb] = as_bf8(pk);
                }
            }
#pragma unroll
            for (int dt = 0; dt < 4; ++dt)
#pragma unroll
                for (int kb = 0; kb < 2; ++kb) {
                    const int row = dt * 16 + fr;
                    const bf16x8 vf = *(const bf16x8*)(Vb + swz(row, kb * 4 + quad));
                    O[pp][dt][0] = mfma16(vf, pf[0][kb], O[pp][dt][0]);
                    O[pp][dt][1] = mfma16(vf, pf[1][kb], O[pp][dt][1]);
                }
            {
                const bf16x8 ones = as_bf8((u32x4){0x3F803F80u, 0x3F803F80u, 0x3F803F80u, 0x3F803F80u});
#pragma unroll
                for (int kb = 0; kb < 2; ++kb) { Lacc[pp][0] = mfma16(ones, pf[0][kb], Lacc[pp][0]); Lacc[pp][1] = mfma16(ones, pf[1][kb], Lacc[pp][1]); }
            }
        }
        if (t + 1 < ntile) { *(u32x4*)(Ks + (buf ^ 1) * 8192 + swz(lrow, lch)) = rk; *(u32x4*)(Vs + (buf ^ 1) * 8192 + swz(lrow, lch)) = rv; }
        __syncthreads();
    }
#pragma unroll
    for (int pp = 0; pp < NP; ++pp)
#pragma unroll
        for (int qs = 0; qs < 2; ++qs) {
            const float lt = Lacc[pp][qs][0];
            const float inv = __builtin_amdgcn_rcpf(lt);
#pragma unroll
            for (int dt = 0; dt < 4; ++dt) O[pp][dt][qs] *= inv;
        }
}

template <int MODE>
__device__ void attn_item(PP p, int l, int grp, int b, int head, int qb, unsigned char* smem_blk) {
    const int tid = vtid(), lane = tid & 63, w = __builtin_amdgcn_readfirstlane(tid >> 6), fr = lane & 15, quad = lane >> 4;
    const int Lk = grp ? 1280 : 256;
    const int tokbase = grp ? 8192 + b * 1024 : b * 256;
    const u16* Z = (const u16*)(p->ws + WS_Z);
    u16* MIX = (u16*)(p->ws + WS_MIX);
    const int qcol = MODE ? 768 + head * 64 : head * 64;
    const int mcol = MODE ? 512 + head * 64 : head * 64;
    const u16* Kg = MODE ? (const u16*)(p->ws + WS_KB) + kv_off(grp, b, head, 4, 1280) : (const u16*)(p->ws + WS_KA) + kv_off(grp, b, head >> 2, 2, 1280);
    const u16* Vg = MODE ? (const u16*)(p->ws + WS_VBT) + kv_off(grp, b, head, 4, 1280) : (const u16*)(p->ws + WS_VAT) + kv_off(grp, b, head >> 2, 2, 1280);
    const float cscale = (MODE ? 0.17677669529663687f : 0.125f) * 1.4426950408889634f;

    bf16x8 qf[2][2];
#pragma unroll
    for (int qs = 0; qs < 2; ++qs)
#pragma unroll
        for (int ks = 0; ks < 2; ++ks)
            {
                const u32x4 raw = *(const u32x4*)(Z + (size_t)(tokbase + qb * 128 + w * 32 + qs * 16 + fr) * NIN + qcol + ks * 32 + quad * 8);
                float qv[8]; unpack8(raw, qv);
#pragma unroll
                for (int i = 0; i < 8; ++i) qv[i] *= cscale;
                qf[qs][ks] = as_bf8(pack8(qv));
            }

    f32x4 O[4][2];
    float lam = 0.f, lam_init = 0.f;
    if (MODE == 0) {
        f32x4 O1[1][4][2];
        attn_sweep<1>(Kg, Vg, Lk, qf, smem_blk, O1);
#pragma unroll
        for (int dt = 0; dt < 4; ++dt) { O[dt][0] = O1[0][dt][0]; O[dt][1] = O1[0][dt][1]; }
    } else {
        f32x4 O2[2][4][2];
        attn_sweep<2>(Kg, Vg, Lk, qf, smem_blk, O2);
        float s1 = 0.f, s2 = 0.f;
        for (int i = 0; i < 32; ++i) { s1 += p->in[I_LQ1][l * 32 + i] * p->in[I_LK1][l * 32 + i]; s2 += p->in[I_LQ2][l * 32 + i] * p->in[I_LK2][l * 32 + i]; }
        lam_init = 0.8f - 0.6f * expf(-0.3f * (float)l);
        lam = expf(s1) - expf(s2) + lam_init;
#pragma unroll
        for (int dt = 0; dt < 4; ++dt) { O[dt][0] = O2[0][dt][0] - lam * O2[1][dt][0]; O[dt][1] = O2[0][dt][1] - lam * O2[1][dt][1]; }
    }
#pragma unroll
    for (int qs = 0; qs < 2; ++qs) {
        const int tok = tokbase + qb * 128 + w * 32 + qs * 16 + fr;
        if (MODE == 1) {
            float ss = 0.f;
#pragma unroll
            for (int dt = 0; dt < 4; ++dt)
#pragma unroll
                for (int r = 0; r < 4; ++r) ss += O[dt][qs][r] * O[dt][qs][r];
            ss = rows_sum(ss);
            const float rstd = rsqrtf(ss * (1.f / 64.f) + EPS) * (1.f - lam_init);
#pragma unroll
            for (int dt = 0; dt < 4; ++dt) {
                const f32x4 g4 = *(const f32x4*)(p->in[I_BOG] + l * 64 + dt * 16 + quad * 4);
                O[dt][qs] *= g4 * rstd;
            }
        }
#pragma unroll
        for (int dt = 0; dt < 4; ++dt) {
            const int col = mcol + dt * 16 + quad * 4;
            const u32x2 ur = *(const u32x2*)(Z + (size_t)tok * NIN + 2080 + col);
            u32x2 ov;
            ov.x = pk2(O[dt][qs][0] * silu_f(bflo(ur.x)), O[dt][qs][1] * silu_f(bfhi(ur.x)));
            ov.y = pk2(O[dt][qs][2] * silu_f(bflo(ur.y)), O[dt][qs][3] * silu_f(bfhi(ur.y)));
            *(u32x2*)(MIX + (size_t)tok * DM + col) = ov;
        }
    }
    __syncthreads();
}


__device__ void gla_item(PP p, int l, int grp, int b, int h, int dir, unsigned char* smem) {
    const int tid = vtid(), lane = tid & 63, w = __builtin_amdgcn_readfirstlane(tid >> 6), fr = lane & 15, quad = lane >> 4;
    const int L = grp ? 1024 : 256, nch = L >> 6;
    const int tokbase = grp ? 8192 + b * 1024 : b * 256;
    const u16* Z = (const u16*)(p->ws + WS_Z);
    u16* MIX = (u16*)(p->ws + WS_MIX);
    float* OC = (float*)(p->ws + (dir ? WS_H : WS_OC));
    const u16* Vt = (const u16*)(p->ws + WS_CVT) + kv_off(grp, b, h, 4, 1024);
    u16* QtL = (u16*)smem;
    u16* KtL = (u16*)(smem + 5120);
    u16* KlT = (u16*)(smem + 10240);
    float* Dl = (float*)(smem + 14848);
    const float qscale = 0.17677669529663687f;

    {
        f32x4 Sacc[2][4];
        const float* s0 = (dir ? p->in[I_SCB] : p->in[I_SCF]) + (size_t)((b * 2 + l) * 4 + h) * 32 * 64;
#pragma unroll
        for (int dt = 0; dt < 2; ++dt)
#pragma unroll
            for (int et = 0; et < 4; ++et)
#pragma unroll
                for (int r = 0; r < 4; ++r) Sacc[dt][et][r] = grp ? s0[(dt * 16 + quad * 4 + r) * 64 + et * 16 + fr] : 0.f;
        float4 ng0, ng1; u32x4 nq, nk;
        {
            const int c0 = dir ? nch - 1 : 0;
            const float* gp = (const float*)(p->ws + WS_G) + (size_t)(tokbase + c0 * 64 + lane) * 256 + dir * 128 + h * 32 + 8 * w;
            ng0 = *(const float4*)gp; ng1 = *(const float4*)(gp + 4);
            const size_t zrow = (size_t)(tokbase + c0 * 64 + lane) * NIN;
            nq = *(const u32x4*)(Z + zrow + 1536 + h * 32 + 8 * w); nk = *(const u32x4*)(Z + zrow + 1664 + h * 32 + 8 * w);
        }
        for (int ci = 0; ci < nch; ++ci) {
            const int c = dir ? nch - 1 - ci : ci, t0 = c * 64;
            const float4 g0 = ng0, g1 = ng1; const u32x4 cq = nq, ck = nk;
            bf16x8 vfr[4][2];
#pragma unroll
            for (int et = 0; et < 4; ++et)
#pragma unroll
                for (int jb = 0; jb < 2; ++jb) {
                    vfr[et][jb] = *(const bf16x8*)(Vt + (size_t)(et * 16 + fr) * L + t0 + jb * 32 + quad * 8);
                }
            if (ci + 1 < nch) {
                const int cn = dir ? nch - 2 - ci : ci + 1;
                const float* gp = (const float*)(p->ws + WS_G) + (size_t)(tokbase + cn * 64 + lane) * 256 + dir * 128 + h * 32 + 8 * w;
                ng0 = *(const float4*)gp; ng1 = *(const float4*)(gp + 4);
                const size_t zrow = (size_t)(tokbase + cn * 64 + lane) * NIN;
                nq = *(const u32x4*)(Z + zrow + 1536 + h * 32 + 8 * w); nk = *(const u32x4*)(Z + zrow + 1664 + h * 32 + 8 * w);
            }
            {
                float q[8], k[8], g[8], pre[8];
                g[0] = g0.x; g[1] = g0.y; g[2] = g0.z; g[3] = g0.w; g[4] = g1.x; g[5] = g1.y; g[6] = g1.z; g[7] = g1.w;
#pragma unroll
                for (int dd = 0; dd < 8; ++dd) pre[dd] = g[dd];
                unpack8(cq, q);
                unpack8(ck, k);
#pragma unroll
                for (int off = 1; off < 64; off <<= 1)
#pragma unroll
                    for (int dd = 0; dd < 8; ++dd) { const float tv = __shfl_up(pre[dd], off); if (lane >= off) pre[dd] += tv; }
                float qt[8], kt8[8];
#pragma unroll
                for (int dd = 0; dd < 8; ++dd) {
                    const float tot = __shfl(pre[dd], 63);
                    const float cum = dir ? (tot - pre[dd] + g[dd]) : pre[dd];
                    qt[dd] = q[dd] * qscale * __expf(cum);
                    kt8[dd] = k[dd] * __expf(-cum);
                    const float kl = k[dd] * __expf(tot - cum);
                    KlT[(8 * w + dd) * 72 + lane] = (u16)(pk2(kl, 0.f) & 0xffff);
                    if (lane == 0) Dl[8 * w + dd] = __expf(tot);
                }
                *(u32x4*)(QtL + lane * 40 + 8 * w) = pack8(qt);
                *(u32x4*)(KtL + lane * 40 + 8 * w) = pack8(kt8);
            }
            __syncthreads();
            const bf16x8 qstd = *(const bf16x8*)(QtL + (16 * w + fr) * 40 + quad * 8);
            f32x4 PT[4];
#pragma unroll
            for (int jt = 0; jt < 4; ++jt) {
                PT[jt] = (f32x4){0.f, 0.f, 0.f, 0.f};
                const bool need = dir ? (jt >= w) : (jt <= w);
                if (need) {
                    const bf16x8 kfr = *(const bf16x8*)(KtL + (jt * 16 + fr) * 40 + quad * 8);
                    PT[jt] = mfma16(kfr, qstd, PT[jt]);
                    if (jt == w) {
#pragma unroll
                        for (int r = 0; r < 4; ++r) { const int jj = quad * 4 + r; const bool keep = dir ? (jj >= fr) : (jj <= fr); if (!keep) PT[jt][r] = 0.f; }
                    }
                }
            }
            bf16x8 pa[2];
#pragma unroll
            for (int jb = 0; jb < 2; ++jb) {
                u32x4 pk; pk.x = pk2(PT[2 * jb][0], PT[2 * jb][1]); pk.y = pk2(PT[2 * jb][2], PT[2 * jb][3]);
                pk.z = pk2(PT[2 * jb + 1][0], PT[2 * jb + 1][1]); pk.w = pk2(PT[2 * jb + 1][2], PT[2 * jb + 1][3]);
                pa[jb] = as_bf8(pk);
            }
            bf16x8 qrel;
            {
                const u32x2 a = *(const u32x2*)(QtL + (16 * w + fr) * 40 + quad * 4), a2 = *(const u32x2*)(QtL + (16 * w + fr) * 40 + 16 + quad * 4);
                qrel = as_bf8((u32x4){a.x, a.y, a2.x, a2.y});
            }
            f32x4 Oacc[4];
#pragma unroll
            for (int et = 0; et < 4; ++et) {
                Oacc[et] = (f32x4){0.f, 0.f, 0.f, 0.f};
                Oacc[et] = mfma16(pa[0], vfr[et][0], Oacc[et]);
                Oacc[et] = mfma16(pa[1], vfr[et][1], Oacc[et]);
                u32x4 sb; sb.x = pk2(Sacc[0][et][0], Sacc[0][et][1]); sb.y = pk2(Sacc[0][et][2], Sacc[0][et][3]);
                sb.z = pk2(Sacc[1][et][0], Sacc[1][et][1]); sb.w = pk2(Sacc[1][et][2], Sacc[1][et][3]);
                Oacc[et] = mfma16(qrel, as_bf8(sb), Oacc[et]);
            }
#pragma unroll
            for (int dt = 0; dt < 2; ++dt) {
                bf16x8 klf[2];
#pragma unroll
                for (int jb = 0; jb < 2; ++jb) {
                    const u32x2 a = *(const u32x2*)(KlT + (dt * 16 + fr) * 72 + jb * 32 + quad * 4), a2 = *(const u32x2*)(KlT + (dt * 16 + fr) * 72 + jb * 32 + 16 + quad * 4);
                    klf[jb] = as_bf8((u32x4){a.x, a.y, a2.x, a2.y});
                }
                float dec[4];
#pragma unroll
                for (int r = 0; r < 4; ++r) dec[r] = Dl[dt * 16 + quad * 4 + r];
#pragma unroll
                for (int et = 0; et < 4; ++et) {
                    f32x4 hacc;
#pragma unroll
                    for (int r = 0; r < 4; ++r) hacc[r] = dec[r] * Sacc[dt][et][r];
                    hacc = mfma16(klf[0], vfr[et][0], hacc);
                    hacc = mfma16(klf[1], vfr[et][1], hacc);
                    Sacc[dt][et] = hacc;
                }
            }
#pragma unroll
            for (int r = 0; r < 4; ++r) {
                const int tok = tokbase + t0 + 16 * w + quad * 4 + r;
                float* ocp = OC + (size_t)tok * 256 + h * 64 + fr;
#pragma unroll
                for (int et = 0; et < 4; ++et) ocp[et * 16] = Oacc[et][r];
            }
            __syncthreads();
        }
        if (!grp && w == 0) {
            float* so = p->out + (dir ? OUT_SB : OUT_SF) + (size_t)((b * 2 + l) * 4 + h) * 32 * 64;
#pragma unroll
            for (int dt = 0; dt < 2; ++dt)
#pragma unroll
                for (int et = 0; et < 4; ++et)
#pragma unroll
                    for (int r = 0; r < 4; ++r) so[(dt * 16 + quad * 4 + r) * 64 + et * 16 + fr] = Sacc[dt][et][r];
        }
        __syncthreads();
    }
}

__device__ __forceinline__ void gla_combine(PP p, int l, int grp, int b, int h) {
    const int tid = opaque_tid(), l16 = tid & 15, rowl = tid >> 4;
    const int L = grp ? 1024 : 256, tokbase = grp ? 8192 + b * 1024 : b * 256;
    const float* OCf = (const float*)(p->ws + WS_OC);
    const float* OCb = (const float*)(p->ws + WS_H);
    const u16* Z = (const u16*)(p->ws + WS_Z);
    u16* MIX = (u16*)(p->ws + WS_MIX);
    const float4 g = *(const float4*)(p->in[I_COG] + l * 64 + l16 * 4);
#pragma unroll 4
    for (int r0 = 0; r0 < L; r0 += 32) {
        const size_t tok = (size_t)(tokbase + r0 + rowl);
        const float4 a = *(const float4*)(OCf + tok * 256 + h * 64 + l16 * 4), c = *(const float4*)(OCb + tok * 256 + h * 64 + l16 * 4);
        const float o0 = a.x + c.x, o1 = a.y + c.y, o2 = a.z + c.z, o3 = a.w + c.w;
        float ss = o0 * o0 + o1 * o1 + o2 * o2 + o3 * o3;
        ss = sum16(ss);
        const float rstd = rsqrtf(ss * (1.f / 64.f) + EPS);
        const u32x2 ur = *(const u32x2*)(Z + tok * NIN + 2080 + 768 + h * 64 + l16 * 4);
        u32x2 ov;
        ov.x = pk2(o0 * rstd * g.x * silu_f(bflo(ur.x)), o1 * rstd * g.y * silu_f(bfhi(ur.x)));
        ov.y = pk2(o2 * rstd * g.z * silu_f(bflo(ur.y)), o3 * rstd * g.w * silu_f(bfhi(ur.y)));
        *(u32x2*)(MIX + tok * DM + 768 + h * 64 + l16 * 4) = ov;
    }
}

__device__ void mix_phase(PP p, int l, int ctr_idx, unsigned char* smem_blk) {
    unsigned* ctr = (unsigned*)(p->ws + WS_CTR) + ctr_idx;
    volatile int* s_item = (volatile int*)(smem_blk + 65024);
    const int hb = half_id();
    unsigned char* smem = smem_blk + hb * 65536;
    for (;;) {
        if (opaque_tid() == 0) *s_item = (int)atomicAdd(ctr, 1u);
        __syncthreads();
        const int pi = __builtin_amdgcn_readfirstlane(*s_item);
        __syncthreads();
#if PROBE_DUP == 1
        if (pi >= 928 + 256) break;
        const int pj = pi < 928 ? pi : pi - 928 + 160;
#elif PROBE_DUP == 2
        if (pi >= 928 + 384) break;
        const int pj = pi < 928 ? pi : pi - 928 + 544;
#elif PROBE_DUP == 3
        if (pi >= 928 + 128) break;
        const int pj = pi < 928 ? pi : pi - 928 + 32;
#else
        if (pi >= 928) break;
        const int pj = pi;
#endif
        const int idx = 2 * pj + hb;
        asm volatile("" : "+s"(p));
        int kind, grp, b, h, qb = 0;
        if (idx < 64) { kind = 0; grp = 1; b = idx >> 3; h = (idx >> 1) & 3; qb = idx & 1; }
        else if (idx < 320) { const int j = idx - 64; kind = 1; grp = 1; b = j >> 5; h = (j >> 3) & 3; qb = j & 7; }
        else if (idx < 832) { const int j = idx - 320; kind = 2; grp = 1; b = j >> 6; h = (j >> 3) & 7; qb = j & 7; }
        else if (idx < 1088) { const int j = idx - 832; kind = 0; grp = 0; b = j >> 3; h = (j >> 1) & 3; qb = j & 1; }
        else if (idx < 1344) { const int j = idx - 1088; kind = 1; grp = 0; b = j >> 3; h = (j >> 1) & 3; qb = j & 1; }
        else { const int j = idx - 1344; kind = 2; grp = 0; b = j >> 4; h = (j >> 1) & 7; qb = j & 1; }
        if (kind == 0) { gla_item(p, l, grp, b, h, qb, smem); gla_combine(p, l, grp, b, h); }
        else if (kind == 1) attn_item<1>(p, l, grp, b, h, qb, smem_blk);
        else attn_item<0>(p, l, grp, b, h, qb, smem_blk);
    }
}

#define XB_TMO      128
#define XB_XCNT(j)  (256  + 64 * (j))
#define XB_XSUB(j)  (1280 + 64 * (j))
#define XB_XGEN(j)  (2304 + 64 * (j))
#define XB_TOP      3328
#define XB_TOPGEN   3392
#define XCD_BAR_WORDS 3456
#define XB_SPIN_CAP (1u << 18)
#define LAS __attribute__((address_space(3)))

__device__ __forceinline__ unsigned xb_ld(unsigned* p)              { return __hip_atomic_load(p, __ATOMIC_RELAXED, __HIP_MEMORY_SCOPE_AGENT); }
__device__ __forceinline__ unsigned xb_add(unsigned* p, unsigned v) { return __hip_atomic_fetch_add(p, v, __ATOMIC_RELAXED, __HIP_MEMORY_SCOPE_AGENT); }
__device__ __forceinline__ unsigned xb_xcc_id() { return (unsigned)__builtin_amdgcn_s_getreg((3 << 11) | 20) & 0xFu; }
#define XB_SPIN(cond, bar) do { unsigned _sp = 0; while (cond) { __builtin_amdgcn_s_sleep(1); \
    if ((++_sp & 255u) == 0u) { if (xb_ld(&(bar)[XB_TMO])) break; if (_sp > XB_SPIN_CAP) { atomicAdd(&(bar)[XB_TMO], 1u); break; } } } } while (0)

struct XcdBarrier {
    unsigned* bar; unsigned x;
    volatile LAS unsigned* st;
};

__device__ __forceinline__ XcdBarrier xcd_barrier_post(unsigned* bar, volatile LAS unsigned* st) {
    XcdBarrier b; b.bar = bar; b.x = xb_xcc_id(); b.st = st;
    if (threadIdx.x == 0) (void)xb_add(&bar[XB_XCNT(b.x)], 1u);
    return b;
}
__device__ __forceinline__ void xcd_barrier_complete(unsigned* bar, unsigned x, unsigned& nloc, unsigned& nx) {
    const unsigned G = gridDim.x * gridDim.y * gridDim.z;
    unsigned sum, cnt, mine, sp = 0u;
    for (;;) {
        sum = 0u; cnt = 0u; mine = 0u;
#pragma unroll
        for (unsigned j = 0; j < 16; ++j) { const unsigned c = xb_ld(&bar[XB_XCNT(j)]); sum += c; cnt += (c > 0u) ? 1u : 0u; mine = (j == x) ? c : mine; }
        if (sum == G) break;
        __builtin_amdgcn_s_sleep(1);
        if ((++sp & 255u) == 0u) { if (xb_ld(&bar[XB_TMO])) break; if (sp > XB_SPIN_CAP) { atomicAdd(&bar[XB_TMO], 1u); break; } }
    }
    nloc = mine > 0u ? mine : 1u; nx = cnt > 0u ? cnt : 1u;
}

__device__ __forceinline__ void xcd_barrier(const XcdBarrier& b) {
    asm volatile("s_waitcnt vmcnt(0)" ::: "memory");
    __syncthreads();
    if (threadIdx.x == 0) {
        unsigned* bar = b.bar;
        __builtin_amdgcn_s_waitcnt(0);
        unsigned nloc = b.st[0], nx = b.st[1];
        if (nloc == 0u) { xcd_barrier_complete(bar, b.x, nloc, nx); b.st[0] = nloc; b.st[1] = nx; }
        const unsigned old = xb_add(&bar[XB_XSUB(b.x)], 1u);
        const unsigned gen = old / nloc;
        if (old + 1u == (gen + 1u) * nloc) {
            __builtin_amdgcn_fence(__ATOMIC_RELEASE, "agent");
            asm volatile("s_waitcnt vmcnt(0)" ::: "memory");
            const unsigned og = xb_add(&bar[XB_TOP], 1u);
            const unsigned tg = og / nx;
            if (og + 1u == (tg + 1u) * nx) xb_add(&bar[XB_TOPGEN], 1u);
            else XB_SPIN(xb_ld(&bar[XB_TOPGEN]) == tg, bar);
            __builtin_amdgcn_fence(__ATOMIC_ACQUIRE, "agent");
            xb_add(&bar[XB_XGEN(b.x)], 1u);
            asm volatile("s_waitcnt vmcnt(0)" ::: "memory");
        } else {
            XB_SPIN(xb_ld(&bar[XB_XGEN(b.x)]) == gen, bar);
            __builtin_amdgcn_fence(__ATOMIC_ACQUIRE, "agent");
            asm volatile("s_waitcnt vmcnt(0)" ::: "memory");
        }
    }
    __syncthreads();
}


__global__ void __launch_bounds__(NTHREADS, 1) mega_fwd(Params p_unused, int ph_lo, int ph_hi) {
    extern __shared__ __attribute__((aligned(16))) unsigned char smem[];
    __shared__ uint4 xb_words;
    if (threadIdx.x == 0) xb_words = make_uint4(0u, 0u, 0u, 0u);
    __syncthreads();
    const XcdBarrier xb = xcd_barrier_post((unsigned*)(((PP)__builtin_amdgcn_kernarg_segment_ptr())->ws + WS_BAR), (volatile LAS unsigned*)&xb_words);
    unsigned char* const smem_h = smem + half_id() * 65536;
    for (int ph = ph_lo; ph < ph_hi; ++ph) {
        PP p = (PP)__builtin_amdgcn_kernarg_segment_ptr();
        asm volatile("" : "+s"(p));
        for (int rep = 0; rep < (((PROBE_MASK >> ph) & 1) ? 2 : 1); ++rep) {
            if (rep) xcd_barrier(xb);
            if (ph == 0) prep_phase(p, smem_h);
            else if (ph == 1) prenorm_phase(p);
            else {
                const int l = (ph - 2) / 5, s = (ph - 2) % 5;
                if (s == 0 || s == 3) {
                    const bool inp = (s == 0);
                    gemm_phase((const u16*)(p->ws + (inp ? WS_H : WS_MIX)), inp ? (const u16*)(p->ws + WS_WIN) + (size_t)l * NINP * DM : (const u16*)(p->ws + WS_WOUT) + (size_t)l * DM * DM,
                               inp ? 12 : 4, (u16*)(p->ws + WS_Z), inp ? NIN : DM, inp ? 2 : 0, smem);
                }
                else if (s == 1) post_phase(p, l, smem_h);
                else if (s == 2) mix_phase(p, l, 2 * rep + l, smem);
                else final_phase(p, l);
            }
        }
        if (ph + 1 < ph_hi) { if (ph_hi == 0x7fffffff) cg::this_grid().sync(); else xcd_barrier(xb); }
    }
}

extern "C" void kernel_launch(void* const* d_in, const int* in_sizes, int n_in, void* d_out, int out_size, void* d_ws, size_t ws_size, hipStream_t stream) {
    static int grid = 0;
    if (grid == 0) {
        if (n_in != 28 || ws_size < WS_END) { fprintf(stderr, "kernel_launch: unexpected n_in %d / ws_size %zu (need %zu)\n", n_in, ws_size, (size_t)WS_END); grid = -1; return; }
        int dev = 0, cus = 0, per_cu = 0;
        (void)hipGetDevice(&dev);
        (void)hipDeviceGetAttribute(&cus, hipDeviceAttributeMultiprocessorCount, dev);
        if (hipFuncSetAttribute((const void*)mega_fwd, hipFuncAttributeMaxDynamicSharedMemorySize, 131072) != hipSuccess) fprintf(stderr, "kernel_launch: hipFuncSetAttribute failed\n");
        if (hipOccupancyMaxActiveBlocksPerMultiprocessor(&per_cu, (const void*)mega_fwd, NTHREADS, 131072) != hipSuccess || per_cu < 1) { fprintf(stderr, "kernel_launch: occupancy query failed (%d)\n", per_cu); per_cu = 1; }
        if (per_cu > 1) per_cu = 1;
        grid = cus * per_cu;
        fprintf(stderr, "kernel_launch: cus %d per_cu %d grid %d\n", cus, per_cu, grid);
    }
    if (grid < 0) return;
    (void)hipMemsetAsync((unsigned char*)d_ws + WS_BAR, 0, 3456 * 4, stream);
    Params p{};
    for (int i = 0; i < 28; ++i) p.in[i] = (const float*)d_in[i];
    p.out = (float*)d_out; p.ws = (unsigned char*)d_ws;
#if N_LAUNCH_SPLIT
    for (int ph = 0; ph < 12; ++ph) hipLaunchKernelGGL(mega_fwd, dim3(grid), dim3(NTHREADS), 131072, stream, p, ph, ph + 1);
#else
    int lo = 0, hi = 12;
    void* args[] = {&p, &lo, &hi};
    hipError_t e = hipLaunchCooperativeKernel((const void*)mega_fwd, dim3(grid), dim3(NTHREADS), args, 131072, stream);
    if (e != hipSuccess) fprintf(stderr, "cooperative launch failed: %s (grid %d)\n", hipGetErrorString(e), grid);
#endif
}
```

```cpp
#include <hip/hip_runtime.h>
#include <hip/hip_cooperative_groups.h>
#include <cstdio>
#include <cstdint>
namespace cg = cooperative_groups;

typedef unsigned short u16;
typedef short bf16x8 __attribute__((ext_vector_type(8)));
typedef float f32x4 __attribute__((ext_vector_type(4)));
typedef unsigned u32x4 __attribute__((ext_vector_type(4)));
typedef unsigned u32x2 __attribute__((ext_vector_type(2)));

#ifndef PROBE_MASK
#define PROBE_MASK 0
#endif
#ifndef PROBE_DUP
#define PROBE_DUP 0
#endif
#define N_LAUNCH_SPLIT 0

constexpr int NTOK = 16384, DM = 1024, NIN = 3104, NINP = 3200;
constexpr int NTHREADS = 512;
constexpr int VT = 256;
constexpr float EPS = 1e-6f;

constexpr size_t WS_WIN  = 0;
constexpr size_t WS_WOUT = WS_WIN  + (size_t)2 * NINP * DM * 2;
constexpr size_t WS_MOD  = WS_WOUT + (size_t)2 * DM * DM * 2;
constexpr size_t WS_ROPE = WS_MOD  + (size_t)2 * 9 * 3072 * 4;
constexpr size_t WS_CTR  = WS_ROPE + 64 * 16 * 8;
constexpr size_t WS_H    = WS_CTR  + 256;
constexpr size_t WS_Z    = WS_H    + (size_t)NTOK * DM * 2;
constexpr size_t WS_MIX  = WS_Z    + (size_t)NTOK * NIN * 2;
constexpr size_t WS_KA   = WS_MIX  + (size_t)NTOK * DM * 2;
constexpr size_t KA_ELEMS = (size_t)(32 * 2 * 256 + 8 * 2 * 1280) * 64;
constexpr size_t KB_ELEMS = (size_t)(32 * 4 * 256 + 8 * 4 * 1280) * 64;
constexpr size_t CV_ELEMS = (size_t)(32 * 4 * 256 + 8 * 4 * 1024) * 64;
constexpr size_t WS_VAT  = WS_KA  + KA_ELEMS * 2;
constexpr size_t WS_KB   = WS_VAT + KA_ELEMS * 2;
constexpr size_t WS_VBT  = WS_KB  + KB_ELEMS * 2;
constexpr size_t WS_CVT  = WS_VBT + KB_ELEMS * 2;
constexpr size_t WS_OC   = WS_CVT + CV_ELEMS * 2;
constexpr size_t WS_G    = WS_OC  + (size_t)NTOK * 256 * 4;
constexpr size_t WS_BAR  = WS_G   + (size_t)NTOK * 256 * 4;
constexpr size_t WS_END  = WS_BAR + 3456 * 4;

constexpr size_t OUT_Y   = 0;
constexpr size_t OUT_AK  = 16777216;
constexpr size_t OUT_AV  = OUT_AK + 2097152;
constexpr size_t OUT_BK  = OUT_AV + 2097152;
constexpr size_t OUT_BV  = OUT_BK + 4194304;
constexpr size_t OUT_SF  = OUT_BV + 4194304;
constexpr size_t OUT_SB  = OUT_SF + 524288;

struct Params {
    const float* in[28];
    float* out;
    unsigned char* ws;
};
typedef const __attribute__((address_space(4))) Params* PP;
enum { I_XP = 0, I_XS, I_C, I_CAK, I_CAV, I_CBK, I_CBV, I_SCF, I_SCB, I_CCTX, I_WMOD, I_BMOD, I_GPRE, I_GPOST, I_WIN, I_WOUT,
       I_AQG, I_AKG, I_LQ1, I_LK1, I_LQ2, I_LK2, I_BOG, I_CWF, I_CBF, I_CWB, I_CBB, I_COG };

__device__ __forceinline__ int opaque_tid() { int t = threadIdx.x; asm volatile("" : "+v"(t)); return t; }
__device__ __forceinline__ int vtid() { return opaque_tid() & 255; }
__device__ __forceinline__ int half_id() { return __builtin_amdgcn_readfirstlane(threadIdx.x >> 8); }
typedef __bf16 bf16x2_t __attribute__((ext_vector_type(2)));
typedef float f32x2_t __attribute__((ext_vector_type(2)));
__device__ __forceinline__ unsigned pk2(float lo, float hi) { const f32x2_t v = {lo, hi}; return __builtin_bit_cast(unsigned, __builtin_convertvector(v, bf16x2_t)); }
__device__ __forceinline__ float bflo(unsigned w) { return __uint_as_float(w << 16); }
__device__ __forceinline__ float bfhi(unsigned w) { return __uint_as_float(w & 0xffff0000u); }
__device__ __forceinline__ float fast_exp2(float x) { return __builtin_amdgcn_exp2f(x); }
__device__ __forceinline__ float silu_f(float v) { return v * __builtin_amdgcn_rcpf(1.f + __expf(-v)); }
template <int CTRL> __device__ __forceinline__ float dppf(float v) { return __int_as_float(__builtin_amdgcn_mov_dpp(__float_as_int(v), CTRL, 0xf, 0xf, true)); }
__device__ __forceinline__ float xor1f(float v) { return dppf<0xB1>(v); }
__device__ __forceinline__ float xor2f(float v) { return dppf<0x4E>(v); }
__device__ __forceinline__ float sum8(float v) { v += xor1f(v); v += xor2f(v); v += dppf<0x141>(v); return v; }
__device__ __forceinline__ float sum16(float v) { v = sum8(v); v += dppf<0x140>(v); return v; }
__device__ __forceinline__ float rows_sum(float v) {
    unsigned u = __float_as_uint(v);
    auto r = __builtin_amdgcn_permlane16_swap(u, u, false, false);
    v = __uint_as_float(r[0]) + __uint_as_float(r[1]);
    u = __float_as_uint(v);
    auto r2 = __builtin_amdgcn_permlane32_swap(u, u, false, false);
    return __uint_as_float(r2[0]) + __uint_as_float(r2[1]);
}
__device__ __forceinline__ float wave_sum(float v) { return rows_sum(sum16(v)); }
__device__ __forceinline__ f32x4 mfma16(bf16x8 a, bf16x8 b, f32x4 c) { return __builtin_amdgcn_mfma_f32_16x16x32_bf16(a, b, c, 0, 0, 0); }
__device__ __forceinline__ bf16x8 as_bf8(u32x4 v) { return __builtin_bit_cast(bf16x8, v); }
__device__ __forceinline__ int swz(int row, int chunk) { return row * 128 + ((chunk ^ ((row >> 1) & 7)) << 4); }
__device__ __forceinline__ size_t kv_off(int grp, int b, int h, int H, int LS) {
    return grp ? ((size_t)32 * H * 256 + (size_t)(b * H + h) * LS) * 64 : (size_t)(b * H + h) * 256 * 64;
}

__device__ void prep_phase(PP p, unsigned char* smem) {
    const int tid = vtid(), lane = tid & 63, w = __builtin_amdgcn_readfirstlane(tid >> 6), hb = half_id();
    constexpr int NMOD = 192, NT_IN = 16 * 50, NT_OUT = 16 * 16;
    constexpr int NITEMS = NMOD + 2 * (NT_IN + NT_OUT) + 1;
    float* MODW = (float*)(p->ws + WS_MOD);
    for (int it0 = blockIdx.x * 2; it0 < NITEMS + 1; it0 += gridDim.x * 2) {
        const int it = it0 + hb;
        asm volatile("" : "+s"(p));
        if (it < NMOD) {
            const int l = it / 96, cgp = it % 96;
            float* red = (float*)smem;
            const int cq = tid & 7, kg = tid >> 3;
            const float* wp = p->in[I_WMOD] + (size_t)l * 1024 * 3072 + cgp * 32 + cq * 4;
            const float* cc = p->in[I_C]; const float* cx = p->in[I_CCTX];
            float acc[9][4];
#pragma unroll
            for (int r = 0; r < 9; ++r) { acc[r][0] = 0.f; acc[r][1] = 0.f; acc[r][2] = 0.f; acc[r][3] = 0.f; }
#pragma unroll 4
            for (int kk = 0; kk < 32; ++kk) {
                const int k = kg * 32 + kk;
                const float4 w4 = *(const float4*)(wp + (size_t)k * 3072);
                float cv[9];
                cv[0] = cx[k];
#pragma unroll
                for (int r = 1; r < 9; ++r) cv[r] = cc[(r - 1) * 1024 + k];
#pragma unroll
                for (int r = 0; r < 9; ++r) { const float s = cv[r] * __builtin_amdgcn_rcpf(1.f + __expf(-cv[r])); acc[r][0] += s * w4.x; acc[r][1] += s * w4.y; acc[r][2] += s * w4.z; acc[r][3] += s * w4.w; }
            }
#pragma unroll
            for (int r = 0; r < 9; ++r)
#pragma unroll
                for (int j = 0; j < 4; ++j) { float v = acc[r][j]; v += dppf<0x128>(v); v = rows_sum(v); acc[r][j] = v; }
            if ((lane >> 3) == 0) {
#pragma unroll
                for (int r = 0; r < 9; ++r)
#pragma unroll
                    for (int j = 0; j < 4; ++j) red[(w * 9 + r) * 32 + cq * 4 + j] = acc[r][j];
            }
            __syncthreads();
            for (int i = tid; i < 288; i += VT) {
                const int r = i >> 5, c = i & 31;
                const float v = red[(0 * 9 + r) * 32 + c] + red[(1 * 9 + r) * 32 + c] + red[(2 * 9 + r) * 32 + c] + red[(3 * 9 + r) * 32 + c] + p->in[I_BMOD][l * 3072 + cgp * 32 + c];
                MODW[(size_t)(l * 9 + r) * 3072 + cgp * 32 + c] = v;
            }
        } else if (it < NITEMS - 1) {
            int r = it - NMOD;
            const float* src; u16* dst; int N, NT;
            if (r < 2 * NT_IN) { const int l = r / NT_IN; r %= NT_IN; src = p->in[I_WIN] + (size_t)l * 1024 * NIN; dst = (u16*)(p->ws + WS_WIN) + (size_t)l * NINP * DM; N = NIN; NT = 50; }
            else { r -= 2 * NT_IN; const int l = r / NT_OUT; r %= NT_OUT; src = p->in[I_WOUT] + (size_t)l * 1024 * 1024; dst = (u16*)(p->ws + WS_WOUT) + (size_t)l * DM * DM; N = 1024; NT = 16; }
            const int kt = r / NT, nt = r % NT, k0 = kt * 64, n0 = nt * 64;
            float* T = (float*)smem;
#pragma unroll
            for (int i = 0; i < 4; ++i) {
                const int rr = (tid >> 4) + 16 * i, c = (tid & 15) * 4;
                float4 v = make_float4(0.f, 0.f, 0.f, 0.f);
                if (n0 + c < N) v = *(const float4*)(src + (size_t)(k0 + rr) * N + n0 + c);
                T[rr * 65 + c] = v.x; T[rr * 65 + c + 1] = v.y; T[rr * 65 + c + 2] = v.z; T[rr * 65 + c + 3] = v.w;
            }
            __syncthreads();
            const int n = tid >> 2, kq = tid & 3;
            u32x4 o0, o1;
            o0.x = pk2(T[(kq * 16 + 0) * 65 + n], T[(kq * 16 + 1) * 65 + n]);   o0.y = pk2(T[(kq * 16 + 2) * 65 + n], T[(kq * 16 + 3) * 65 + n]);
            o0.z = pk2(T[(kq * 16 + 4) * 65 + n], T[(kq * 16 + 5) * 65 + n]);   o0.w = pk2(T[(kq * 16 + 6) * 65 + n], T[(kq * 16 + 7) * 65 + n]);
            o1.x = pk2(T[(kq * 16 + 8) * 65 + n], T[(kq * 16 + 9) * 65 + n]);   o1.y = pk2(T[(kq * 16 + 10) * 65 + n], T[(kq * 16 + 11) * 65 + n]);
            o1.z = pk2(T[(kq * 16 + 12) * 65 + n], T[(kq * 16 + 13) * 65 + n]); o1.w = pk2(T[(kq * 16 + 14) * 65 + n], T[(kq * 16 + 15) * 65 + n]);
            u16* d = dst + (size_t)(n0 + n) * DM + k0 + kq * 16;
            *(u32x4*)d = o0; *(u32x4*)(d + 8) = o1;
        } else {
            float2* tab = (float2*)(p->ws + WS_ROPE);
            for (int i = tid; i < (it == NITEMS - 1 ? 1024 : 0); i += VT) {
                const int pos = i >> 4, fi = i & 15;
                const float freq = powf(10000.f, -(float)fi / 16.f);
                const float ang = (float)pos * freq;
                float s, c; sincosf(ang, &s, &c);
                tab[i] = make_float2(c, s);
            }
            if (it == NITEMS - 1 && tid < 8) ((unsigned*)(p->ws + WS_CTR))[tid] = 0u;
        }
        __syncthreads();
    }
}

__device__ __forceinline__ void prenorm_phase(PP p) {
    const int tid = opaque_tid(), lane = tid & 63, w = __builtin_amdgcn_readfirstlane(tid >> 6);
    const float* MODW = (const float*)(p->ws + WS_MOD);
    u16* H = (u16*)(p->ws + WS_H);
#pragma unroll 2
    for (int row = blockIdx.x * 8 + w; row < NTOK; row += gridDim.x * 8) {
        const float* xr = row < 8192 ? p->in[I_XP] + (size_t)row * DM : p->in[I_XS] + (size_t)(row - 8192) * DM;
        const int mrow = row < 8192 ? 0 : 1 + ((row - 8192) >> 10);
        const float* md = MODW + (size_t)mrow * 3072;
        float4 v[4]; float ss = 0.f;
#pragma unroll
        for (int j = 0; j < 4; ++j) { v[j] = *(const float4*)(xr + lane * 4 + 256 * j); ss += v[j].x * v[j].x + v[j].y * v[j].y + v[j].z * v[j].z + v[j].w * v[j].w; }
        const float rstd = rsqrtf(wave_sum(ss) * (1.f / DM) + EPS);
#pragma unroll
        for (int j = 0; j < 4; ++j) {
            const int c = lane * 4 + 256 * j;
            const float4 g = *(const float4*)(p->in[I_GPRE] + c), sh = *(const float4*)(md + c), scl = *(const float4*)(md + 1024 + c);
            u32x2 o;
            o.x = pk2(v[j].x * rstd * g.x * (1.f + scl.x) + sh.x, v[j].y * rstd * g.y * (1.f + scl.y) + sh.y);
            o.y = pk2(v[j].z * rstd * g.z * (1.f + scl.z) + sh.z, v[j].w * rstd * g.w * (1.f + scl.w) + sh.w);
            *(u32x2*)(H + (size_t)row * DM + c) = o;
        }
    }
}

__device__ __forceinline__ void final_phase(PP p, int l) {
    const int tid = opaque_tid(), lane = tid & 63, w = __builtin_amdgcn_readfirstlane(tid >> 6);
    const float* MODW = (const float*)(p->ws + WS_MOD);
    const u16* Y = (const u16*)(p->ws + WS_Z);
    u16* H = (u16*)(p->ws + WS_H);
#pragma unroll 2
    for (int row = blockIdx.x * 8 + w; row < NTOK; row += gridDim.x * 8) {
        const float* xr = (l == 0) ? (row < 8192 ? p->in[I_XP] + (size_t)row * DM : p->in[I_XS] + (size_t)(row - 8192) * DM) : p->out + OUT_Y + (size_t)row * DM;
        const int mrow = row < 8192 ? 0 : 1 + ((row - 8192) >> 10);
        const float* md = MODW + (size_t)(l * 9 + mrow) * 3072;
        float4 y[4], x[4]; float ss = 0.f;
#pragma unroll
        for (int j = 0; j < 4; ++j) {
            { const u32x2 yr = *(const u32x2*)(Y + (size_t)row * DM + lane * 4 + 256 * j); y[j] = make_float4(bflo(yr.x), bfhi(yr.x), bflo(yr.y), bfhi(yr.y)); }
            x[j] = *(const float4*)(xr + lane * 4 + 256 * j);
            ss += y[j].x * y[j].x + y[j].y * y[j].y + y[j].z * y[j].z + y[j].w * y[j].w;
        }
        const float rstd = rsqrtf(wave_sum(ss) * (1.f / DM) + EPS);
        float ss2 = 0.f;
#pragma unroll
        for (int j = 0; j < 4; ++j) {
            const int c = lane * 4 + 256 * j;
            const float4 g = *(const float4*)(p->in[I_GPOST] + l * DM + c), gt = *(const float4*)(md + 2048 + c);
            x[j].x += gt.x * (y[j].x * rstd * g.x); x[j].y += gt.y * (y[j].y * rstd * g.y); x[j].z += gt.z * (y[j].z * rstd * g.z); x[j].w += gt.w * (y[j].w * rstd * g.w);
            *(float4*)(p->out + OUT_Y + (size_t)row * DM + c) = x[j];
            ss2 += x[j].x * x[j].x + x[j].y * x[j].y + x[j].z * x[j].z + x[j].w * x[j].w;
        }
        if (l == 0) {
            const float rstd2 = rsqrtf(wave_sum(ss2) * (1.f / DM) + EPS);
            const float* md1 = MODW + (size_t)(9 + mrow) * 3072;
#pragma unroll
            for (int j = 0; j < 4; ++j) {
                const int c = lane * 4 + 256 * j;
                const float4 g = *(const float4*)(p->in[I_GPRE] + DM + c), sh = *(const float4*)(md1 + c), scl = *(const float4*)(md1 + 1024 + c);
                u32x2 o;
                o.x = pk2(x[j].x * rstd2 * g.x * (1.f + scl.x) + sh.x, x[j].y * rstd2 * g.y * (1.f + scl.y) + sh.y);
                o.y = pk2(x[j].z * rstd2 * g.z * (1.f + scl.z) + sh.z, x[j].w * rstd2 * g.w * (1.f + scl.w) + sh.w);
                *(u32x2*)(H + (size_t)row * DM + c) = o;
            }
        }
    }
}

typedef __attribute__((address_space(3))) unsigned* lds_u32p;
__device__ __forceinline__ void dma16(const void* g, void* l) { __builtin_amdgcn_global_load_lds((const unsigned*)g, (lds_u32p)l, 16, 0, 0); }

__device__ __forceinline__ void gemm_phase(const u16* __restrict__ A, const u16* __restrict__ BT, int ntn, u16* __restrict__ C, int ldc, int tail16, unsigned char* smem) {
    const int tid = opaque_tid(), lane = tid & 63, w = __builtin_amdgcn_readfirstlane(tid >> 6), wm = w >> 2, wn = w & 3, fr = lane & 15, quad = lane >> 4;
    const int lrow = tid >> 3, lch = tid & 7, gch = lch ^ ((lrow >> 1) & 7);
    unsigned char* As = smem;
    unsigned char* Bs = smem + 65536;
    const int xcd = blockIdx.x & 7, jloc = blockIdx.x >> 3, nloc = gridDim.x >> 3, per_x = 8 * ntn;
    for (int tl = jloc; tl < per_x; tl += nloc) {
        const int mt_ = xcd * 8 + (tl & 7), nt_ = tl >> 3, m0 = mt_ * 256, n0 = nt_ * 256;
        const u16* gA = A + (size_t)(m0 + lrow) * DM + gch * 8;
        const u16* gB = BT + (size_t)(n0 + lrow) * DM + gch * 8;
        f32x4 acc[8][4];
#pragma unroll
        for (int i = 0; i < 8; ++i)
#pragma unroll
            for (int j = 0; j < 4; ++j) acc[i][j] = (f32x4){0.f, 0.f, 0.f, 0.f};
#pragma unroll
        for (int i = 0; i < 4; ++i) { dma16(gA + (size_t)i * 64 * DM, As + i * 8192 + tid * 16); dma16(gB + (size_t)i * 64 * DM, Bs + i * 8192 + tid * 16); }
        __syncthreads();
        for (int kt = 0; kt < 16; ++kt) {
            const int buf = kt & 1;
            if (kt < 15) {
#pragma unroll
                for (int i = 0; i < 4; ++i) {
                    dma16(gA + (size_t)i * 64 * DM + (kt + 1) * 64, As + (buf ^ 1) * 32768 + i * 8192 + tid * 16);
                    dma16(gB + (size_t)i * 64 * DM + (kt + 1) * 64, Bs + (buf ^ 1) * 32768 + i * 8192 + tid * 16);
                }
            }
            const unsigned char* Ab = As + buf * 32768; const unsigned char* Bb = Bs + buf * 32768;
#pragma unroll
            for (int ks = 0; ks < 2; ++ks) {
                bf16x8 bfr[4];
#pragma unroll
                for (int j = 0; j < 4; ++j) bfr[j] = *(const bf16x8*)(Bb + swz(wn * 64 + j * 16 + fr, ks * 4 + quad));
#pragma unroll
                for (int ih = 0; ih < 2; ++ih) {
                    bf16x8 af[4];
#pragma unroll
                    for (int i = 0; i < 4; ++i) af[i] = *(const bf16x8*)(Ab + swz(wm * 128 + (ih * 4 + i) * 16 + fr, ks * 4 + quad));
#pragma unroll
                    for (int i = 0; i < 4; ++i)
#pragma unroll
                        for (int j = 0; j < 4; ++j) acc[ih * 4 + i][j] = mfma16(bfr[j], af[i], acc[ih * 4 + i][j]);
                }
            }
            __syncthreads();
        }
#pragma unroll
        for (int i = 0; i < 8; ++i)
#pragma unroll
            for (int jp = 0; jp < 2; ++jp) {
                const unsigned ax = pk2(acc[i][2 * jp][0], acc[i][2 * jp][1]), ay = pk2(acc[i][2 * jp][2], acc[i][2 * jp][3]);
                const unsigned bx = pk2(acc[i][2 * jp + 1][0], acc[i][2 * jp + 1][1]), by = pk2(acc[i][2 * jp + 1][2], acc[i][2 * jp + 1][3]);
                const auto sx = __builtin_amdgcn_permlane16_swap(ax, bx, false, false);
                const auto sy = __builtin_amdgcn_permlane16_swap(ay, by, false, false);
                const int row = m0 + wm * 128 + i * 16 + fr;
                const int col = n0 + wn * 64 + ((quad & 1) ? (2 * jp + 1) * 16 + (quad - 1) * 4 : (2 * jp) * 16 + quad * 4);
                *(u32x4*)(C + (size_t)row * ldc + col) = (u32x4){sx[0], sy[0], sx[1], sy[1]};
            }
    }
    if (tail16 > 0) {
        const int ntask = 1024 * tail16;
        for (int task = blockIdx.x * 8 + w; task < ntask; task += gridDim.x * 8) {
            const int mt16 = task / tail16, nt16 = task % tail16, col0 = ntn * 256 + nt16 * 16;
            const u16* ap = A + (size_t)(mt16 * 16 + fr) * DM + quad * 8;
            const u16* bp = BT + (size_t)(col0 + fr) * DM + quad * 8;
            f32x4 acc = (f32x4){0.f, 0.f, 0.f, 0.f};
#pragma unroll 8
            for (int ks = 0; ks < 32; ++ks) acc = mfma16(*(const bf16x8*)(bp + ks * 32), *(const bf16x8*)(ap + ks * 32), acc);
            u32x2 o; o.x = pk2(acc[0], acc[1]); o.y = pk2(acc[2], acc[3]);
            *(u32x2*)(C + (size_t)(mt16 * 16 + fr) * ldc + col0 + quad * 4) = o;
        }
    }
}

__device__ __forceinline__ float log_sigmoid_f(float x) { return fminf(x, 0.f) - __logf(1.f + __expf(-fabsf(x))); }
__device__ __forceinline__ void unpack8(u32x4 r, float (&v)[8]) {
    v[0] = bflo(r.x); v[1] = bfhi(r.x); v[2] = bflo(r.y); v[3] = bfhi(r.y); v[4] = bflo(r.z); v[5] = bfhi(r.z); v[6] = bflo(r.w); v[7] = bfhi(r.w);
}
__device__ __forceinline__ u32x4 pack8(const float (&v)[8]) { u32x4 o; o.x = pk2(v[0], v[1]); o.y = pk2(v[2], v[3]); o.z = pk2(v[4], v[5]); o.w = pk2(v[6], v[7]); return o; }
__device__ __forceinline__ void store8f(float* d, const float (&v)[8]) { *(float4*)d = make_float4(v[0], v[1], v[2], v[3]); *(float4*)(d + 4) = make_float4(v[4], v[5], v[6], v[7]); }
__device__ __forceinline__ void vt_store(u16* Tl, u32x4 raw, int tok_l, int sub, u16* vt_base, int rowlen, int tcol0) {
    const int tid = vtid();
    const int tc = tok_l ^ (sub * 4);
    Tl[(sub * 8 + 0) * 40 + tc] = (u16)(raw.x & 0xffff); Tl[(sub * 8 + 1) * 40 + tc] = (u16)(raw.x >> 16);
    Tl[(sub * 8 + 2) * 40 + tc] = (u16)(raw.y & 0xffff); Tl[(sub * 8 + 3) * 40 + tc] = (u16)(raw.y >> 16);
    Tl[(sub * 8 + 4) * 40 + tc] = (u16)(raw.z & 0xffff); Tl[(sub * 8 + 5) * 40 + tc] = (u16)(raw.z >> 16);
    Tl[(sub * 8 + 6) * 40 + tc] = (u16)(raw.w & 0xffff); Tl[(sub * 8 + 7) * 40 + tc] = (u16)(raw.w >> 16);
    __syncthreads();
    const int d = tid >> 2, part = tid & 3;
    const int sx = (d >> 3) * 4;
    const u32x2 pa = *(const u32x2*)(Tl + d * 40 + ((part * 4) ^ sx)), pb = *(const u32x2*)(Tl + d * 40 + ((16 + part * 4) ^ sx));
    *(u32x4*)(vt_base + (size_t)d * rowlen + tcol0 + part * 8) = (u32x4){pa.x, pa.y, pb.x, pb.y};
    __syncthreads();
}

__device__ void post_phase(PP p, int l, unsigned char* smem) {
    const int tid = vtid(), tok_l = tid >> 3, sub = tid & 7, hb = half_id();
    u16* Tl = (u16*)smem;
    u16* Z = (u16*)(p->ws + WS_Z);
    u16* KA = (u16*)(p->ws + WS_KA); u16* VAT = (u16*)(p->ws + WS_VAT);
    u16* KB = (u16*)(p->ws + WS_KB); u16* VBT = (u16*)(p->ws + WS_VBT); u16* CVT = (u16*)(p->ws + WS_CVT);
    const float2* tab = (const float2*)(smem + 8192);
    const float* gwL = (const float*)(smem + 16384);
    const float* gbL = (const float*)(smem + 36864);
    {
        const float2* tabg = (const float2*)(p->ws + WS_ROPE);
        for (int i = tid; i < 1024; i += VT) ((float2*)(smem + 8192))[i] = tabg[i];
        for (int i = tid; i < 4096; i += VT) ((float*)(smem + 16384))[((i >> 11) * 4 + ((i & 127) >> 5)) * 584 + ((i >> 7) & 15) * 36 + (i & 31)] = ((i >> 11) ? p->in[I_CWB] : p->in[I_CWF])[l * 2048 + (i & 2047)];
        if (tid < 256) ((float*)(smem + 36864))[tid] = ((tid >> 7) ? p->in[I_CBB] : p->in[I_CBF])[l * 128 + (tid & 127)];
    }
    float gq[8], gk[8];
#pragma unroll
    for (int i = 0; i < 8; ++i) { gq[i] = p->in[I_AQG][l * 64 + sub * 8 + i]; gk[i] = p->in[I_AKG][l * 64 + sub * 8 + i]; }
    __syncthreads();
    for (int it0 = blockIdx.x * 2; it0 < 512 + 768; it0 += gridDim.x * 2) {
        const int it = it0 + hb;
        asm volatile("" : "+s"(p));
        if (it < 512) {
            const int tok0 = it * 32, grp = tok0 >= 8192;
            const int b = grp ? (tok0 - 8192) >> 10 : tok0 >> 8, t0 = grp ? (tok0 - 8192) & 1023 : tok0 & 255;
            const int tok = tok0 + tok_l, t = t0 + tok_l;
            const int Lk = grp ? 1280 : 256, kof = grp ? 256 : 0;
            const int prow = t >> 6, pcol = t & 63;
            u32x4 raw_next = *(const u32x4*)(Z + (size_t)tok * NIN + sub * 8);
            for (int u = 0; u < 28; ++u) {
                const int col0 = u < 24 ? u * 64 : 1792 + (u - 24) * 64;
                u16* zp = Z + (size_t)tok * NIN + col0 + sub * 8;
                u32x4 raw = raw_next;
                if (u + 1 < 28) { const int coln = (u + 1) < 24 ? (u + 1) * 64 : 1792 + (u + 1 - 24) * 64; raw_next = *(const u32x4*)(Z + (size_t)tok * NIN + coln + sub * 8); }
                if (u < 10) {
                    float v[8]; unpack8(raw, v);
                    float ss = 0.f;
#pragma unroll
                    for (int i = 0; i < 8; ++i) ss += v[i] * v[i];
                    ss = sum8(ss);
                    const float rstd = rsqrtf(ss * (1.f / 64.f) + EPS);
#pragma unroll
                    for (int i = 0; i < 8; ++i) v[i] = v[i] * rstd * (u < 8 ? gq[i] : gk[i]);
                    if (u >= 8 && !grp) store8f(p->out + OUT_AK + ((size_t)((b * 2 + l) * 2 + (u - 8)) * 256 + t) * 64 + sub * 8, v);
                    if (grp) {
                        const int pos = (sub & 4) ? pcol : prow;
#pragma unroll
                        for (int i = 0; i < 8; ++i) {
                            const float pr = xor2f(v[i]);
                            const float2 cs = tab[pos * 16 + (sub & 1) * 8 + i];
                            v[i] = (sub & 2) ? v[i] * cs.x + pr * cs.y : v[i] * cs.x - pr * cs.y;
                        }
                    }
                    const u32x4 o = pack8(v);
                    if (u < 8) *(u32x4*)zp = o;
                    else *(u32x4*)(KA + kv_off(grp, b, u - 8, 2, 1280) + (size_t)(kof + t) * 64 + sub * 8) = o;
                } else if (u < 12) {
                    const int kvh = u - 10;
                    if (!grp) { float v[8]; unpack8(raw, v); store8f(p->out + OUT_AV + ((size_t)((b * 2 + l) * 2 + kvh) * 256 + t) * 64 + sub * 8, v); }
                    vt_store(Tl, raw, tok_l, sub, VAT + kv_off(grp, b, kvh, 2, 1280), Lk, kof + t0);
                } else if (u < 20) {
                    const int isk = u >= 16, h = isk ? u - 16 : u - 12;
                    float v[8]; unpack8(raw, v);
                    if (isk && !grp) store8f(p->out + OUT_BK + ((size_t)((b * 2 + l) * 4 + h) * 256 + t) * 64 + sub * 8, v);
                    if (grp) {
                        const int pos = (sub & 2) ? pcol : prow;
#pragma unroll
                        for (int i = 0; i < 8; ++i) {
                            const float pr = xor1f(v[i]);
                            const float2 cs = tab[pos * 16 + 2 * i];
                            v[i] = (sub & 1) ? v[i] * cs.x + pr * cs.y : v[i] * cs.x - pr * cs.y;
                        }
                        raw = pack8(v);
                    }
                    if (!isk) { if (grp) *(u32x4*)zp = raw; }
                    else *(u32x4*)(KB + kv_off(grp, b, h, 4, 1280) + (size_t)(kof + t) * 64 + sub * 8) = raw;
                } else if (u < 24) {
                    const int h = u - 20;
                    if (!grp) { float v[8]; unpack8(raw, v); store8f(p->out + OUT_BV + ((size_t)((b * 2 + l) * 4 + h) * 256 + t) * 64 + sub * 8, v); }
                    vt_store(Tl, raw, tok_l, sub, VBT + kv_off(grp, b, h, 4, 1280), Lk, kof + t0);
                } else {
                    const int h = u - 24;
                    vt_store(Tl, raw, tok_l, sub, CVT + kv_off(grp, b, h, 4, 1024), grp ? 1024 : 256, t0);
                }
            }
            {
                const int dir = sub >> 2, c0 = (sub & 3) * 32;
                float lr[16];
                { float t8[8];
                  unpack8(*(const u32x4*)(Z + (size_t)tok * NIN + 2048 + dir * 16), t8);
#pragma unroll
                  for (int i = 0; i < 8; ++i) lr[i] = t8[i];
                  unpack8(*(const u32x4*)(Z + (size_t)tok * NIN + 2048 + dir * 16 + 8), t8);
#pragma unroll
                  for (int i = 0; i < 8; ++i) lr[8 + i] = t8[i]; }
                const float* gw = gwL + sub * 584;
                const float* gb = gbL + dir * 128 + c0;
                float* gout = (float*)(p->ws + WS_G) + (size_t)tok * 256 + dir * 128 + c0;
#pragma unroll 1
                for (int cc = 0; cc < 8; ++cc) {
                    float4 a = *(const float4*)(gb + cc * 4);
#pragma unroll
                    for (int r = 0; r < 16; ++r) { const float4 w4 = *(const float4*)(gw + r * 36 + cc * 4); a.x += lr[r] * w4.x; a.y += lr[r] * w4.y; a.z += lr[r] * w4.z; a.w += lr[r] * w4.w; }
                    a.x = log_sigmoid_f(a.x) * (1.f / 16.f); a.y = log_sigmoid_f(a.y) * (1.f / 16.f); a.z = log_sigmoid_f(a.z) * (1.f / 16.f); a.w = log_sigmoid_f(a.w) * (1.f / 16.f);
                    *(float4*)(gout + cc * 4) = a;
                }
            }
        } else {
            const int idx = it - 512, cu = idx % 12, rest = idx / 12, ktile = rest & 7, b = rest >> 3;
            const int key0 = ktile * 32, key = key0 + tok_l;
            const float* src; int hh, H;
            if (cu < 2) { hh = cu; H = 2; src = p->in[I_CAK]; } else if (cu < 4) { hh = cu - 2; H = 2; src = p->in[I_CAV]; }
            else if (cu < 8) { hh = cu - 4; H = 4; src = p->in[I_CBK]; } else { hh = cu - 8; H = 4; src = p->in[I_CBV]; }
            const float* sp = src + ((size_t)((b * 2 + l) * H + hh) * 256 + key) * 64 + sub * 8;
            const float4 a0 = *(const float4*)sp, a1 = *(const float4*)(sp + 4);
            u32x4 o; o.x = pk2(a0.x, a0.y); o.y = pk2(a0.z, a0.w); o.z = pk2(a1.x, a1.y); o.w = pk2(a1.z, a1.w);
            if (cu < 2) *(u32x4*)(KA + kv_off(1, b, hh, 2, 1280) + (size_t)key * 64 + sub * 8) = o;
            else if (cu < 4) vt_store(Tl, o, tok_l, sub, VAT + kv_off(1, b, hh, 2, 1280), 1280, key0);
            else if (cu < 8) *(u32x4*)(KB + kv_off(1, b, hh, 4, 1280) + (size_t)key * 64 + sub * 8) = o;
            else vt_store(Tl, o, tok_l, sub, VBT + kv_off(1, b, hh, 4, 1280), 1280, key0);
        }
    }
}

__device__ __forceinline__ float quad_max(float v) {
    unsigned u = __float_as_uint(v);
    auto r = __builtin_amdgcn_permlane16_swap(u, u, false, false);
    v = fmaxf(__uint_as_float(r[0]), __uint_as_float(r[1]));
    u = __float_as_uint(v);
    auto r2 = __builtin_amdgcn_permlane32_swap(u, u, false, false);
    return fmaxf(__uint_as_float(r2[0]), __uint_as_float(r2[1]));
}

template <int NP>
__device__ __forceinline__ void attn_sweep(const u16* __restrict__ Kg, const u16* __restrict__ Vg, int Lk, const bf16x8 (&qf)[2][2], unsigned char* smem, f32x4 (&O)[NP][4][2]) {
    const int tid = vtid(), lane = tid & 63, fr = lane & 15, quad = lane >> 4;
    float mrun[NP][2]; f32x4 Lacc[NP][2];
#pragma unroll
    for (int pp = 0; pp < NP; ++pp)
#pragma unroll
        for (int qs = 0; qs < 2; ++qs) {
            mrun[pp][qs] = -INFINITY; Lacc[pp][qs] = (f32x4){0.f, 0.f, 0.f, 0.f};
#pragma unroll
            for (int dt = 0; dt < 4; ++dt) O[pp][dt][qs] = (f32x4){0.f, 0.f, 0.f, 0.f};
        }
    unsigned char* Ks = smem;
    unsigned char* Vs = smem + 16384;
    const int t512 = opaque_tid(), lrow = t512 >> 3, lch = t512 & 7;
    u32x4 rk, rv;
    rk = *(const u32x4*)(Kg + (size_t)lrow * 64 + lch * 8); rv = *(const u32x4*)(Vg + (size_t)lrow * Lk + lch * 8);
    *(u32x4*)(Ks + swz(lrow, lch)) = rk; *(u32x4*)(Vs + swz(lrow, lch)) = rv;
    __syncthreads();
    const int ntile = Lk >> 6;
    for (int t = 0; t < ntile; ++t) {
        const int buf = t & 1;
        if (t + 1 < ntile) {
            rk = *(const u32x4*)(Kg + (size_t)((t + 1) * 64 + lrow) * 64 + lch * 8);
            rv = *(const u32x4*)(Vg + (size_t)lrow * Lk + (t + 1) * 64 + lch * 8);
        }
        const unsigned char* Kb = Ks + buf * 8192; const unsigned char* Vb = Vs + buf * 8192;
#pragma unroll
        for (int pp = 0; pp < NP; ++pp) {
            f32x4 S[4][2];
#pragma unroll
            for (int kt = 0; kt < 4; ++kt) { S[kt][0] = (f32x4){0.f, 0.f, 0.f, 0.f}; S[kt][1] = (f32x4){0.f, 0.f, 0.f, 0.f}; }
#pragma unroll
            for (int kt = 0; kt < 4; ++kt)
#pragma unroll
                for (int ks = (NP == 2 ? pp : 0); ks < (NP == 2 ? pp + 1 : 2); ++ks) {
                    const bf16x8 kf = *(const bf16x8*)(Kb + swz(kt * 16 + fr, ks * 4 + quad));
                    S[kt][0] = mfma16(kf, qf[0][ks], S[kt][0]);
                    S[kt][1] = mfma16(kf, qf[1][ks], S[kt][1]);
                }
            bf16x8 pf[2][2];
#pragma unroll
            for (int qs = 0; qs < 2; ++qs) {
                float mx = -INFINITY;
#pragma unroll
                for (int kt = 0; kt < 4; ++kt)
#pragma unroll
                    for (int r = 0; r < 4; ++r) mx = fmaxf(mx, S[kt][qs][r]);
                mx = quad_max(mx);
                const float mold = mrun[pp][qs];
                const float mnew = fmaxf(mold, mx);
                mrun[pp][qs] = mnew;
                const f32x4 mv = (f32x4){mnew, mnew, mnew, mnew};
#pragma unroll
                for (int kt = 0; kt < 4; ++kt) {
                    const f32x4 d = S[kt][qs] - mv;
                    f32x4 e; e[0] = fast_exp2(d[0]); e[1] = fast_exp2(d[1]); e[2] = fast_exp2(d[2]); e[3] = fast_exp2(d[3]);
                    S[kt][qs] = e;
                }
                if (__builtin_amdgcn_ballot_w64(mnew != mold) != 0ull) {
                    const float alpha = fast_exp2(mold - mnew);
                    Lacc[pp][qs] *= alpha;
#pragma unroll
                    for (int dt = 0; dt < 4; ++dt) O[pp][dt][qs] *= alpha;
                }
#pragma unroll
                for (int kb = 0; kb < 2; ++kb) {
                    u32x4 pk; pk.x = pk2(S[2 * kb][qs][0], S[2 * kb][qs][1]); pk.y = pk2(S[2 * kb][qs][2], S[2 * kb][qs][3]);
                    pk.z = pk2(S[2 * kb + 1][qs][0], S[2 * kb + 1][qs][1]); pk.w = pk2(S[2 * kb + 1][qs][2], S[2 * kb + 1][qs][3]);
                    pf[qs][kb] = as_bf8(pk);
                }
            }
#pragma unroll
            for (int dt = 0; dt < 4; ++dt)
#pragma unroll
                for (int kb = 0; kb < 2; ++kb) {
                    const int row = dt * 16 + fr;
                    const bf16x8 vf = *(const bf16x8*)(Vb + swz(row, kb * 4 + quad));
                    O[pp][dt][0] = mfma16(vf, pf[0][kb], O[pp][dt][0]);
                    O[pp][dt][1] = mfma16(vf, pf[1][kb], O[pp][dt][1]);
                }
            {
                const bf16x8 ones = as_bf8((u32x4){0x3F803F80u, 0x3F803F80u, 0x3F803F80u, 0x3F803F80u});
#pragma unroll
                for (int kb = 0; kb < 2; ++kb) { Lacc[pp][0] = mfma16(ones, pf[0][kb], Lacc[pp][0]); Lacc[pp][1] = mfma16(ones, pf[1][kb], Lacc[pp][1]); }
            }
        }
        if (t + 1 < ntile) { *(u32x4*)(Ks + (buf ^ 1) * 8192 + swz(lrow, lch)) = rk; *(u32x4*)(Vs + (buf ^ 1) * 8192 + swz(lrow, lch)) = rv; }
        __syncthreads();
    }
#pragma unroll
    for (int pp = 0; pp < NP; ++pp)
#pragma unroll
        for (int qs = 0; qs < 2; ++qs) {
            const float lt = Lacc[pp][qs][0];
            const float inv = __builtin_amdgcn_rcpf(lt);
#pragma unroll
            for (int dt = 0; dt < 4; ++dt) O[pp][dt][qs] *= inv;
        }
}

template <int MODE>
__device__ void attn_item(PP p, int l, int grp, int b, int head, int qb, unsigned char* smem_blk) {
    const int tid = vtid(), lane = tid & 63, w = __builtin_amdgcn_readfirstlane(tid >> 6), fr = lane & 15, quad = lane >> 4;
    const int Lk = grp ? 1280 : 256;
    const int tokbase = grp ? 8192 + b * 1024 : b * 256;
    const u16* Z = (const u16*)(p->ws + WS_Z);
    u16* MIX = (u16*)(p->ws + WS_MIX);
    const int qcol = MODE ? 768 + head * 64 : head * 64;
    const int mcol = MODE ? 512 + head * 64 : head * 64;
    const u16* Kg = MODE ? (const u16*)(p->ws + WS_KB) + kv_off(grp, b, head, 4, 1280) : (const u16*)(p->ws + WS_KA) + kv_off(grp, b, head >> 2, 2, 1280);
    const u16* Vg = MODE ? (const u16*)(p->ws + WS_VBT) + kv_off(grp, b, head, 4, 1280) : (const u16*)(p->ws + WS_VAT) + kv_off(grp, b, head >> 2, 2, 1280);
    const float cscale = (MODE ? 0.17677669529663687f : 0.125f) * 1.4426950408889634f;

    bf16x8 qf[2][2];
#pragma unroll
    for (int qs = 0; qs < 2; ++qs)
#pragma unroll
        for (int ks = 0; ks < 2; ++ks)
            {
                const u32x4 raw = *(const u32x4*)(Z + (size_t)(tokbase + qb * 128 + w * 32 + qs * 16 + fr) * NIN + qcol + ks * 32 + quad * 8);
                float qv[8]; unpack8(raw, qv);
#pragma unroll
                for (int i = 0; i < 8; ++i) qv[i] *= cscale;
                qf[qs][ks] = as_bf8(pack8(qv));
            }

    f32x4 O[4][2];
    float lam = 0.f, lam_init = 0.f;
    if (MODE == 0) {
        f32x4 O1[1][4][2];
        attn_sweep<1>(Kg, Vg, Lk, qf, smem_blk, O1);
#pragma unroll
        for (int dt = 0; dt < 4; ++dt) { O[dt][0] = O1[0][dt][0]; O[dt][1] = O1[0][dt][1]; }
    } else {
        f32x4 O2[2][4][2];
        attn_sweep<2>(Kg, Vg, Lk, qf, smem_blk, O2);
        float s1 = 0.f, s2 = 0.f;
        for (int i = 0; i < 32; ++i) { s1 += p->in[I_LQ1][l * 32 + i] * p->in[I_LK1][l * 32 + i]; s2 += p->in[I_LQ2][l * 32 + i] * p->in[I_LK2][l * 32 + i]; }
        lam_init = 0.8f - 0.6f * expf(-0.3f * (float)l);
        lam = expf(s1) - expf(s2) + lam_init;
#pragma unroll
        for (int dt = 0; dt < 4; ++dt) { O[dt][0] = O2[0][dt][0] - lam * O2[1][dt][0]; O[dt][1] = O2[0][dt][1] - lam * O2[1][dt][1]; }
    }
#pragma unroll
    for (int qs = 0; qs < 2; ++qs) {
        const int tok = tokbase + qb * 128 + w * 32 + qs * 16 + fr;
        if (MODE == 1) {
            float ss = 0.f;
#pragma unroll
            for (int dt = 0; dt < 4; ++dt)
#pragma unroll
                for (int r = 0; r < 4; ++r) ss += O[dt][qs][r] * O[dt][qs][r];
            ss = rows_sum(ss);
            const float rstd = rsqrtf(ss * (1.f / 64.f) + EPS) * (1.f - lam_init);
#pragma unroll
            for (int dt = 0; dt < 4; ++dt) {
                const f32x4 g4 = *(const f32x4*)(p->in[I_BOG] + l * 64 + dt * 16 + quad * 4);
                O[dt][qs] *= g4 * rstd;
            }
        }
#pragma unroll
        for (int dt = 0; dt < 4; ++dt) {
            const int col = mcol + dt * 16 + quad * 4;
            const u32x2 ur = *(const u32x2*)(Z + (size_t)tok * NIN + 2080 + col);
            u32x2 ov;
            ov.x = pk2(O[dt][qs][0] * silu_f(bflo(ur.x)), O[dt][qs][1] * silu_f(bfhi(ur.x)));
            ov.y = pk2(O[dt][qs][2] * silu_f(bflo(ur.y)), O[dt][qs][3] * silu_f(bfhi(ur.y)));
            *(u32x2*)(MIX + (size_t)tok * DM + col) = ov;
        }
    }
    __syncthreads();
}


__device__ void gla_item(PP p, int l, int grp, int b, int h, int dir, unsigned char* smem) {
    const int tid = vtid(), lane = tid & 63, w = __builtin_amdgcn_readfirstlane(tid >> 6), fr = lane & 15, quad = lane >> 4;
    const int L = grp ? 1024 : 256, nch = L >> 6;
    const int tokbase = grp ? 8192 + b * 1024 : b * 256;
    const u16* Z = (const u16*)(p->ws + WS_Z);
    u16* MIX = (u16*)(p->ws + WS_MIX);
    float* OC = (float*)(p->ws + (dir ? WS_H : WS_OC));
    const u16* Vt = (const u16*)(p->ws + WS_CVT) + kv_off(grp, b, h, 4, 1024);
    u16* QtL = (u16*)smem;
    u16* KtL = (u16*)(smem + 5120);
    u16* KlT = (u16*)(smem + 10240);
    float* Dl = (float*)(smem + 14848);
    const float qscale = 0.17677669529663687f;

    {
        f32x4 Sacc[2][4];
        const float* s0 = (dir ? p->in[I_SCB] : p->in[I_SCF]) + (size_t)((b * 2 + l) * 4 + h) * 32 * 64;
#pragma unroll
        for (int dt = 0; dt < 2; ++dt)
#pragma unroll
            for (int et = 0; et < 4; ++et)
#pragma unroll
                for (int r = 0; r < 4; ++r) Sacc[dt][et][r] = grp ? s0[(dt * 16 + quad * 4 + r) * 64 + et * 16 + fr] : 0.f;
        float4 ng0, ng1; u32x4 nq, nk;
        {
            const int c0 = dir ? nch - 1 : 0;
            const float* gp = (const float*)(p->ws + WS_G) + (size_t)(tokbase + c0 * 64 + lane) * 256 + dir * 128 + h * 32 + 8 * w;
            ng0 = *(const float4*)gp; ng1 = *(const float4*)(gp + 4);
            const size_t zrow = (size_t)(tokbase + c0 * 64 + lane) * NIN;
            nq = *(const u32x4*)(Z + zrow + 1536 + h * 32 + 8 * w); nk = *(const u32x4*)(Z + zrow + 1664 + h * 32 + 8 * w);
        }
        for (int ci = 0; ci < nch; ++ci) {
            const int c = dir ? nch - 1 - ci : ci, t0 = c * 64;
            const float4 g0 = ng0, g1 = ng1; const u32x4 cq = nq, ck = nk;
            bf16x8 vfr[4][2];
#pragma unroll
            for (int et = 0; et < 4; ++et)
#pragma unroll
                for (int jb = 0; jb < 2; ++jb) {
                    vfr[et][jb] = *(const bf16x8*)(Vt + (size_t)(et * 16 + fr) * L + t0 + jb * 32 + quad * 8);
                }
            if (ci + 1 < nch) {
                const int cn = dir ? nch - 2 - ci : ci + 1;
                const float* gp = (const float*)(p->ws + WS_G) + (size_t)(tokbase + cn * 64 + lane) * 256 + dir * 128 + h * 32 + 8 * w;
                ng0 = *(const float4*)gp; ng1 = *(const float4*)(gp + 4);
                const size_t zrow = (size_t)(tokbase + cn * 64 + lane) * NIN;
                nq = *(const u32x4*)(Z + zrow + 1536 + h * 32 + 8 * w); nk = *(const u32x4*)(Z + zrow + 1664 + h * 32 + 8 * w);
            }
            {
                float q[8], k[8], g[8], pre[8];
                g[0] = g0.x; g[1] = g0.y; g[2] = g0.z; g[3] = g0.w; g[4] = g1.x; g[5] = g1.y; g[6] = g1.z; g[7] = g1.w;
#pragma unroll
                for (int dd = 0; dd < 8; ++dd) pre[dd] = g[dd];
                unpack8(cq, q);
                unpack8(ck, k);
#pragma unroll
                for (int off = 1; off < 64; off <<= 1)
#pragma unroll
                    for (int dd = 0; dd < 8; ++dd) { const float tv = __shfl_up(pre[dd], off); if (lane >= off) pre[dd] += tv; }
                float qt[8], kt8[8];
#pragma unroll
                for (int dd = 0; dd < 8; ++dd) {
                    const float tot = __shfl(pre[dd], 63);
                    const float cum = dir ? (tot - pre[dd] + g[dd]) : pre[dd];
                    qt[dd] = q[dd] * qscale * __expf(cum);
                    kt8[dd] = k[dd] * __expf(-cum);
                    const float kl = k[dd] * __expf(tot - cum);
                    KlT[(8 * w + dd) * 72 + lane] = (u16)(pk2(kl, 0.f) & 0xffff);
                    if (lane == 0) Dl[8 * w + dd] = __expf(tot);
                }
                *(u32x4*)(QtL + lane * 40 + 8 * w) = pack8(qt);
                *(u32x4*)(KtL + lane * 40 + 8 * w) = pack8(kt8);
            }
            __syncthreads();
            const bf16x8 qstd = *(const bf16x8*)(QtL + (16 * w + fr) * 40 + quad * 8);
            f32x4 PT[4];
#pragma unroll
            for (int jt = 0; jt < 4; ++jt) {
                PT[jt] = (f32x4){0.f, 0.f, 0.f, 0.f};
                const bool need = dir ? (jt >= w) : (jt <= w);
                if (need) {
                    const bf16x8 kfr = *(const bf16x8*)(KtL + (jt * 16 + fr) * 40 + quad * 8);
                    PT[jt] = mfma16(kfr, qstd, PT[jt]);
                    if (jt == w) {
#pragma unroll
                        for (int r = 0; r < 4; ++r) { const int jj = quad * 4 + r; const bool keep = dir ? (jj >= fr) : (jj <= fr); if (!keep) PT[jt][r] = 0.f; }
                    }
                }
            }
            bf16x8 pa[2];
#pragma unroll
            for (int jb = 0; jb < 2; ++jb) {
                u32x4 pk; pk.x = pk2(PT[2 * jb][0], PT[2 * jb][1]); pk.y = pk2(PT[2 * jb][2], PT[2 * jb][3]);
                pk.z = pk2(PT[2 * jb + 1][0], PT[2 * jb + 1][1]); pk.w = pk2(PT[2 * jb + 1][2], PT[2 * jb + 1][3]);
                pa[jb] = as_bf8(pk);
            }
            bf16x8 qrel;
            {
                const u32x2 a = *(const u32x2*)(QtL + (16 * w + fr) * 40 + quad * 4), a2 = *(const u32x2*)(QtL + (16 * w + fr) * 40 + 16 + quad * 4);
                qrel = as_bf8((u32x4){a.x, a.y, a2.x, a2.y});
            }
            f32x4 Oacc[4];
#pragma unroll
            for (int et = 0; et < 4; ++et) {
                Oacc[et] = (f32x4){0.f, 0.f, 0.f, 0.f};
                Oacc[et] = mfma16(pa[0], vfr[et][0], Oacc[et]);
                Oacc[et] = mfma16(pa[1], vfr[et][1], Oacc[et]);
                u32x4 sb; sb.x = pk2(Sacc[0][et][0], Sacc[0][et][1]); sb.y = pk2(Sacc[0][et][2], Sacc[0][et][3]);
                sb.z = pk2(Sacc[1][et][0], Sacc[1][et][1]); sb.w = pk2(Sacc[1][et][2], Sacc[1][et][3]);
                Oacc[et] = mfma16(qrel, as_bf8(sb), Oacc[et]);
            }
#pragma unroll
            for (int dt = 0; dt < 2; ++dt) {
                bf16x8 klf[2];
#pragma unroll
                for (int jb = 0; jb < 2; ++jb) {
                    const u32x2 a = *(const u32x2*)(KlT + (dt * 16 + fr) * 72 + jb * 32 + quad * 4), a2 = *(const u32x2*)(KlT + (dt * 16 + fr) * 72 + jb * 32 + 16 + quad * 4);
                    klf[jb] = as_bf8((u32x4){a.x, a.y, a2.x, a2.y});
                }
                float dec[4];
#pragma unroll
                for (int r = 0; r < 4; ++r) dec[r] = Dl[dt * 16 + quad * 4 + r];
#pragma unroll
                for (int et = 0; et < 4; ++et) {
                    f32x4 hacc;
#pragma unroll
                    for (int r = 0; r < 4; ++r) hacc[r] = dec[r] * Sacc[dt][et][r];
                    hacc = mfma16(klf[0], vfr[et][0], hacc);
                    hacc = mfma16(klf[1], vfr[et][1], hacc);
                    Sacc[dt][et] = hacc;
                }
            }
#pragma unroll
            for (int r = 0; r < 4; ++r) {
                const int tok = tokbase + t0 + 16 * w + quad * 4 + r;
                float* ocp = OC + (size_t)tok * 256 + h * 64 + fr;
#pragma unroll
                for (int et = 0; et < 4; ++et) ocp[et * 16] = Oacc[et][r];
            }
            __syncthreads();
        }
        if (!grp && w == 0) {
            float* so = p->out + (dir ? OUT_SB : OUT_SF) + (size_t)((b * 2 + l) * 4 + h) * 32 * 64;
#pragma unroll
            for (int dt = 0; dt < 2; ++dt)
#pragma unroll
                for (int et = 0; et < 4; ++et)
#pragma unroll
                    for (int r = 0; r < 4; ++r) so[(dt * 16 + quad * 4 + r) * 64 + et * 16 + fr] = Sacc[dt][et][r];
        }
        __syncthreads();
    }
}

__device__ __forceinline__ void gla_combine(PP p, int l, int grp, int b, int h) {
    const int tid = opaque_tid(), l16 = tid & 15, rowl = tid >> 4;
    const int L = grp ? 1024 : 256, tokbase = grp ? 8192 + b * 1024 : b * 256;
    const float* OCf = (const float*)(p->ws + WS_OC);
    const float* OCb = (const float*)(p->ws + WS_H);
    const u16* Z = (const u16*)(p->ws + WS_Z);
    u16* MIX = (u16*)(p->ws + WS_MIX);
    const float4 g = *(const float4*)(p->in[I_COG] + l * 64 + l16 * 4);
#pragma unroll 4
    for (int r0 = 0; r0 < L; r0 += 32) {
        const size_t tok = (size_t)(tokbase + r0 + rowl);
        const float4 a = *(const float4*)(OCf + tok * 256 + h * 64 + l16 * 4), c = *(const float4*)(OCb + tok * 256 + h * 64 + l16 * 4);
        const float o0 = a.x + c.x, o1 = a.y + c.y, o2 = a.z + c.z, o3 = a.w + c.w;
        float ss = o0 * o0 + o1 * o1 + o2 * o2 + o3 * o3;
        ss = sum16(ss);
        const float rstd = rsqrtf(ss * (1.f / 64.f) + EPS);
        const u32x2 ur = *(const u32x2*)(Z + tok * NIN + 2080 + 768 + h * 64 + l16 * 4);
        u32x2 ov;
        ov.x = pk2(o0 * rstd * g.x * silu_f(bflo(ur.x)), o1 * rstd * g.y * silu_f(bfhi(ur.x)));
        ov.y = pk2(o2 * rstd * g.z * silu_f(bflo(ur.y)), o3 * rstd * g.w * silu_f(bfhi(ur.y)));
        *(u32x2*)(MIX + tok * DM + 768 + h * 64 + l16 * 4) = ov;
    }
}

__device__ void mix_phase(PP p, int l, int ctr_idx, unsigned char* smem_blk) {
    unsigned* ctr = (unsigned*)(p->ws + WS_CTR) + ctr_idx;
    volatile int* s_item = (volatile int*)(smem_blk + 65024);
    const int hb = half_id();
    unsigned char* smem = smem_blk + hb * 65536;
    for (;;) {
        if (opaque_tid() == 0) *s_item = (int)atomicAdd(ctr, 1u);
        __syncthreads();
        const int pi = __builtin_amdgcn_readfirstlane(*s_item);
        __syncthreads();
#if PROBE_DUP == 1
        if (pi >= 928 + 256) break;
        const int pj = pi < 928 ? pi : pi - 928 + 160;
#elif PROBE_DUP == 2
        if (pi >= 928 + 384) break;
        const int pj = pi < 928 ? pi : pi - 928 + 544;
#elif PROBE_DUP == 3
        if (pi >= 928 + 128) break;
        const int pj = pi < 928 ? pi : pi - 928 + 32;
#else
        if (pi >= 928) break;
        const int pj = pi;
#endif
        const int idx = 2 * pj + hb;
        asm volatile("" : "+s"(p));
        int kind, grp, b, h, qb = 0;
        if (idx < 64) { kind = 0; grp = 1; b = idx >> 3; h = (idx >> 1) & 3; qb = idx & 1; }
        else if (idx < 320) { const int j = idx - 64; kind = 1; grp = 1; b = j >> 5; h = (j >> 3) & 3; qb = j & 7; }
        else if (idx < 832) { const int j = idx - 320; kind = 2; grp = 1; b = j >> 6; h = (j >> 3) & 7; qb = j & 7; }
        else if (idx < 1088) { const int j = idx - 832; kind = 0; grp = 0; b = j >> 3; h = (j >> 1) & 3; qb = j & 1; }
        else if (idx < 1344) { const int j = idx - 1088; kind = 1; grp = 0; b = j >> 3; h = (j >> 1) & 3; qb = j & 1; }
        else { const int j = idx - 1344; kind = 2; grp = 0; b = j >> 4; h = (j >> 1) & 7; qb = j & 1; }
        if (kind == 0) { gla_item(p, l, grp, b, h, qb, smem); gla_combine(p, l, grp, b, h); }
        else if (kind == 1) attn_item<1>(p, l, grp, b, h, qb, smem_blk);
        else attn_item<0>(p, l, grp, b, h, qb, smem_blk);
    }
}

#define XB_TMO      128
#define XB_XCNT(j)  (256  + 64 * (j))
#define XB_XSUB(j)  (1280 + 64 * (j))
#define XB_XGEN(j)  (2304 + 64 * (j))
#define XB_TOP      3328
#define XB_TOPGEN   3392
#define XCD_BAR_WORDS 3456
#define XB_SPIN_CAP (1u << 18)
#define LAS __attribute__((address_space(3)))

__device__ __forceinline__ unsigned xb_ld(unsigned* p)              { return __hip_atomic_load(p, __ATOMIC_RELAXED, __HIP_MEMORY_SCOPE_AGENT); }
__device__ __forceinline__ unsigned xb_add(unsigned* p, unsigned v) { return __hip_atomic_fetch_add(p, v, __ATOMIC_RELAXED, __HIP_MEMORY_SCOPE_AGENT); }
__device__ __forceinline__ unsigned xb_xcc_id() { return (unsigned)__builtin_amdgcn_s_getreg((3 << 11) | 20) & 0xFu; }
#define XB_SPIN(cond, bar) do { unsigned _sp = 0; while (cond) { __builtin_amdgcn_s_sleep(1); \
    if ((++_sp & 255u) == 0u) { if (xb_ld(&(bar)[XB_TMO])) break; if (_sp > XB_SPIN_CAP) { atomicAdd(&(bar)[XB_TMO], 1u); break; } } } } while (0)

struct XcdBarrier {
    unsigned* bar; unsigned x;
    volatile LAS unsigned* st;
};

__device__ __forceinline__ XcdBarrier xcd_barrier_post(unsigned* bar, volatile LAS unsigned* st) {
    XcdBarrier b; b.bar = bar; b.x = xb_xcc_id(); b.st = st;
    if (threadIdx.x == 0) (void)xb_add(&bar[XB_XCNT(b.x)], 1u);
    return b;
}
__device__ __forceinline__ void xcd_barrier_complete(unsigned* bar, unsigned x, unsigned& nloc, unsigned& nx) {
    const unsigned G = gridDim.x * gridDim.y * gridDim.z;
    unsigned sum, cnt, mine, sp = 0u;
    for (;;) {
        sum = 0u; cnt = 0u; mine = 0u;
#pragma unroll
        for (unsigned j = 0; j < 16; ++j) { const unsigned c = xb_ld(&bar[XB_XCNT(j)]); sum += c; cnt += (c > 0u) ? 1u : 0u; mine = (j == x) ? c : mine; }
        if (sum == G) break;
        __builtin_amdgcn_s_sleep(1);
        if ((++sp & 255u) == 0u) { if (xb_ld(&bar[XB_TMO])) break; if (sp > XB_SPIN_CAP) { atomicAdd(&bar[XB_TMO], 1u); break; } }
    }
    nloc = mine > 0u ? mine : 1u; nx = cnt > 0u ? cnt : 1u;
}

__device__ __forceinline__ void xcd_barrier(const XcdBarrier& b) {
    asm volatile("s_waitcnt vmcnt(0)" ::: "memory");
    __syncthreads();
    if (threadIdx.x == 0) {
        unsigned* bar = b.bar;
        __builtin_amdgcn_s_waitcnt(0);
        unsigned nloc = b.st[0], nx = b.st[1];
        if (nloc == 0u) { xcd_barrier_complete(bar, b.x, nloc, nx); b.st[0] = nloc; b.st[1] = nx; }
        const unsigned old = xb_add(&bar[XB_XSUB(b.x)], 1u);
        const unsigned gen = old / nloc;
        if (old + 1u == (gen + 1u) * nloc) {
            __builtin_amdgcn_fence(__ATOMIC_RELEASE, "agent");
            asm volatile("s_waitcnt vmcnt(0)" ::: "memory");
            const unsigned og = xb_add(&bar[XB_TOP], 1u);
            const unsigned tg = og / nx;
            if (og + 1u == (tg + 1u) * nx) xb_add(&bar[XB_TOPGEN], 1u);
            else XB_SPIN(xb_ld(&bar[XB_TOPGEN]) == tg, bar);
            __builtin_amdgcn_fence(__ATOMIC_ACQUIRE, "agent");
            xb_add(&bar[XB_XGEN(b.x)], 1u);
            asm volatile("s_waitcnt vmcnt(0)" ::: "memory");
        } else {
            XB_SPIN(xb_ld(&bar[XB_XGEN(b.x)]) == gen, bar);
            __builtin_amdgcn_fence(__ATOMIC_ACQUIRE, "agent");
            asm volatile("s_waitcnt vmcnt(0)" ::: "memory");
        }
    }
    __syncthreads();
}


__global__ void __launch_bounds__(NTHREADS, 1) mega_fwd(Params p_unused, int ph_lo, int ph_hi) {
    extern __shared__ __attribute__((aligned(16))) unsigned char smem[];
    __shared__ uint4 xb_words;
    if (threadIdx.x == 0) xb_words = make_uint4(0u, 0u, 0u, 0u);
    __syncthreads();
    const XcdBarrier xb = xcd_barrier_post((unsigned*)(((PP)__builtin_amdgcn_kernarg_segment_ptr())->ws + WS_BAR), (volatile LAS unsigned*)&xb_words);
    unsigned char* const smem_h = smem + half_id() * 65536;
    for (int ph = ph_lo; ph < ph_hi; ++ph) {
        PP p = (PP)__builtin_amdgcn_kernarg_segment_ptr();
        asm volatile("" : "+s"(p));
        for (int rep = 0; rep < (((PROBE_MASK >> ph) & 1) ? 2 : 1); ++rep) {
            if (rep) xcd_barrier(xb);
            if (ph == 0) prep_phase(p, smem_h);
            else if (ph == 1) prenorm_phase(p);
            else {
                const int l = (ph - 2) / 5, s = (ph - 2) % 5;
                if (s == 0 || s == 3) {
                    const bool inp = (s == 0);
                    gemm_phase((const u16*)(p->ws + (inp ? WS_H : WS_MIX)), inp ? (const u16*)(p->ws + WS_WIN) + (size_t)l * NINP * DM : (const u16*)(p->ws + WS_WOUT) + (size_t)l * DM * DM,
                               inp ? 12 : 4, (u16*)(p->ws + WS_Z), inp ? NIN : DM, inp ? 2 : 0, smem);
                }
                else if (s == 1) post_phase(p, l, smem_h);
                else if (s == 2) mix_phase(p, l, 2 * rep + l, smem);
                else final_phase(p, l);
            }
        }
        if (ph + 1 < ph_hi) { if (ph_hi == 0x7fffffff) cg::this_grid().sync(); else xcd_barrier(xb); }
    }
}

extern "C" void kernel_launch(void* const* d_in, const int* in_sizes, int n_in, void* d_out, int out_size, void* d_ws, size_t ws_size, hipStream_t stream) {
    static int grid = 0;
    if (grid == 0) {
        if (n_in != 28 || ws_size < WS_END) { fprintf(stderr, "kernel_launch: unexpected n_in %d / ws_size %zu (need %zu)\n", n_in, ws_size, (size_t)WS_END); grid = -1; return; }
        int dev = 0, cus = 0, per_cu = 0;
        (void)hipGetDevice(&dev);
        (void)hipDeviceGetAttribute(&cus, hipDeviceAttributeMultiprocessorCount, dev);
        if (hipFuncSetAttribute((const void*)mega_fwd, hipFuncAttributeMaxDynamicSharedMemorySize, 131072) != hipSuccess) fprintf(stderr, "kernel_launch: hipFuncSetAttribute failed\n");
        if (hipOccupancyMaxActiveBlocksPerMultiprocessor(&per_cu, (const void*)mega_fwd, NTHREADS, 131072) != hipSuccess || per_cu < 1) { fprintf(stderr, "kernel_launch: occupancy query failed (%d)\n", per_cu); per_cu = 1; }
        if (per_cu > 1) per_cu = 1;
        grid = cus * per_cu;
        fprintf(stderr, "kernel_launch: cus %d per_cu %d grid %d\n", cus, per_cu, grid);
    }
    if (grid < 0) return;
    (void)hipMemsetAsync((unsigned char*)d_ws + WS_BAR, 0, 3456 * 4, stream);
    Params p{};
    for (int i = 0; i < 28; ++i) p.in[i] = (const float*)d_in[i];
    p.out = (float*)d_out; p.ws = (unsigned char*)d_ws;
#if N_LAUNCH_SPLIT
    for (int ph = 0; ph < 12; ++ph) hipLaunchKernelGGL(mega_fwd, dim3(grid), dim3(NTHREADS), 131072, stream, p, ph, ph + 1);
#else
    int lo = 0, hi = 12;
    void* args[] = {&p, &lo, &hi};
    hipError_t e = hipLaunchCooperativeKernel((const void*)mega_fwd, dim3(grid), dim3(NTHREADS), args, 131072, stream);
    if (e != hipSuccess) fprintf(stderr, "cooperative launch failed: %s (grid %d)\n", hipGetErrorString(e), grid);
#endif
}
```
